# Optimizing an MI355X kernel written in HIP

```python
import math
import jax, jax.numpy as jnp
from jax import lax
import numpy as np

D_MODEL = 1024
BATCH = 16
SEQ = 2048
DEPTH = 2

GRID_W = 64
CTX_LEN = 256
N_SUB = 3
D_FF = 2816
EPS = 1e-6
ROPE_THETA = 10000.0
ROPE_DIM = 64
Q_BLOCK = 128
DA_HEADS = 4
DA_DH = 64
DA_DV = 2 * DA_DH
RET_HEADS = 4
RET_DK = 64
RET_DV = 128
RET_CHUNK = 128
GQA_HEADS = 8
GQA_KV = 2
GQA_DH = 64
N_BRANCH = 3
BRANCH_W = 512

PROJ_NAMES = ('a_q', 'a_k', 'a_v', 'b_q', 'b_k', 'b_v', 'b_g', 'c_q', 'c_k', 'c_v', 'gate')
PROJ_SIZES = (DA_HEADS * 2 * DA_DH, DA_HEADS * 2 * DA_DH, DA_HEADS * DA_DV,
              RET_HEADS * RET_DK, RET_HEADS * RET_DK, RET_HEADS * RET_DV, RET_HEADS * RET_DV,
              GQA_HEADS * GQA_DH, GQA_KV * GQA_DH, GQA_KV * GQA_DH, N_BRANCH * D_MODEL)
IN_COLS = sum(PROJ_SIZES)
KV_NAMES = ('a_k', 'a_v', 'b_k', 'b_v', 'c_k', 'c_v')

kernel_name = 'hybrid_gated_diffattn_retention_gqa_block'


def rms_norm(x, g):
    xf = x.astype(jnp.float32)
    y = xf * lax.rsqrt(jnp.mean(xf * xf, axis=-1, keepdims=True) + EPS)
    return (y * g.astype(jnp.float32)).astype(x.dtype)


def axial_rope(n_tok, dim):
    rows = n_tok // GRID_W
    row = jnp.repeat(jnp.arange(rows, dtype=jnp.float32), GRID_W)
    col = jnp.tile(jnp.arange(GRID_W, dtype=jnp.float32), rows)
    n_freq = dim // 4
    inv = ROPE_THETA ** (-jnp.arange(n_freq, dtype=jnp.float32) / n_freq)
    ang = jnp.concatenate([row[:, None] * inv, col[:, None] * inv], axis=-1)
    return jnp.cos(ang), jnp.sin(ang)


def apply_rope(x, cos, sin):
    cos, sin = cos.astype(x.dtype), sin.astype(x.dtype)
    x1, x2 = jnp.split(x, 2, axis=-1)
    return jnp.concatenate([x1 * cos - x2 * sin, x1 * sin + x2 * cos], axis=-1)


def proj_spans():
    spans, lo = {}, 0
    for name, size in zip(PROJ_NAMES, PROJ_SIZES):
        spans[name] = (lo, lo + size)
        lo += size
    return spans


def project(y, w, names):
    spans = proj_spans()
    sel = [spans[nm] for nm in names]
    w_sel = w if names == PROJ_NAMES else jnp.concatenate([w[:, lo:hi] for lo, hi in sel], axis=1)
    p = y @ w_sel
    out, o = {}, 0
    for nm, (lo, hi) in zip(names, sel):
        out[nm] = p[..., o:o + hi - lo]
        o += hi - lo
    return out


def heads(t, n_heads, d):
    b, n, _ = t.shape
    return t.reshape(b, n, n_heads, d).transpose(0, 2, 1, 3)


def merge_heads(t):
    b, h, n, d = t.shape
    return t.transpose(0, 2, 1, 3).reshape(b, n, h * d)


def diff_heads(t):
    b, n, _ = t.shape
    return t.reshape(b, n, DA_HEADS, 2, DA_DH).transpose(0, 2, 3, 1, 4)


def gqa_q_heads(t):
    b, n, _ = t.shape
    return t.reshape(b, n, GQA_KV, GQA_HEADS // GQA_KV, GQA_DH).transpose(0, 2, 3, 1, 4)


def sweep_query_blocks(block_fn, q):
    *lead, n, d = q.shape
    nb = n // Q_BLOCK
    qb = jnp.moveaxis(q.reshape(*lead, nb, Q_BLOCK, d), -3, 0)
    ob = jnp.moveaxis(lax.map(block_fn, qb), 0, -3)
    return ob.reshape(*ob.shape[:-3], n, ob.shape[-1])


def diff_attention(q, k, v, lam):
    scale = DA_DH ** -0.5
    def block(qb):
        s = jnp.einsum('bhcqd,bhctd->bhcqt', qb, k).astype(jnp.float32) * scale
        p = jax.nn.softmax(s, axis=-1)
        a = p[:, :, 0] - lam * p[:, :, 1]
        return jnp.einsum('bhqt,bhtv->bhqv', a.astype(v.dtype), v)
    return sweep_query_blocks(block, q)


def gqa_attention(q, k, v):
    scale = GQA_DH ** -0.5
    def block(qb):
        s = jnp.einsum('bgrqd,bgtd->bgrqt', qb, k).astype(jnp.float32) * scale
        p = jax.nn.softmax(s, axis=-1)
        return jnp.einsum('bgrqt,bgtd->bgrqd', p.astype(v.dtype), v)
    return sweep_query_blocks(block, q)


def retention_chunks(q, k, v, log_gamma, state0):
    b, h, n, _ = q.shape
    dv = v.shape[-1]
    nc = n // RET_CHUNK
    pos = jnp.arange(RET_CHUNK, dtype=jnp.float32)
    rel = pos[:, None] - pos[None, :]
    intra = jnp.where(rel >= 0, jnp.exp(log_gamma[:, None, None] * jnp.maximum(rel, 0.0)), 0.0)
    q_dec = jnp.exp(log_gamma[:, None] * (pos + 1.0))[..., None]
    k_dec = jnp.exp(log_gamma[:, None] * (RET_CHUNK - 1.0 - pos))[..., None]
    s_dec = jnp.exp(log_gamma * RET_CHUNK)[:, None, None]

    def to_chunks(t):
        return jnp.moveaxis(t.astype(jnp.float32).reshape(b, h, nc, RET_CHUNK, t.shape[-1]), 2, 0)

    def step(state, qkv):
        qc, kc, vc = qkv
        att = jnp.einsum('bhid,bhjd->bhij', qc, kc) * intra
        o = jnp.einsum('bhij,bhjv->bhiv', att, vc) + jnp.einsum('bhid,bhdv->bhiv', qc * q_dec, state)
        state = state * s_dec + jnp.einsum('bhjd,bhjv->bhdv', kc * k_dec, vc)
        return state, o

    state, o = lax.scan(step, state0, (to_chunks(q), to_chunks(k), to_chunks(v)))
    return jnp.moveaxis(o, 0, 2).reshape(b, h, n, dv), state


def retention_state(k, v, log_gamma):
    n = k.shape[2]
    w = jnp.exp(log_gamma[:, None] * (n - 1.0 - jnp.arange(n, dtype=jnp.float32)))
    return jnp.einsum('bhjd,bhjv->bhdv', k.astype(jnp.float32) * w[..., None], v.astype(jnp.float32))


def sub_mod(mod, s):
    return mod[:, :, s, 0], mod[:, :, s, 1], mod[:, :, s, 2]


def ffn_sublayer(h, mod3, g_pre, g_post, w_i, w_o):
    shift, scale, gate = mod3
    y = rms_norm(h, g_pre) * (1 + scale) + shift
    a, u = jnp.split(y @ w_i, 2, axis=-1)
    y = (jax.nn.silu(a) * u) @ w_o
    return h + 0.5 * gate * rms_norm(y, g_post)


def merge_branches(outs, gate_pre, b_gate, w_branch, w_out):
    g = jax.nn.sigmoid((gate_pre + b_gate).reshape(*gate_pre.shape[:-1], N_BRANCH, D_MODEL))
    merged = sum(g[..., i, :] * (o @ w_branch[i]) for i, o in enumerate(outs))
    return merged @ w_out


def mixer_sublayer(h, hc, mod3, mod3_c, g_pre, g_post, w_in, b_gate, diff_lambda, diff_norm_g,
                   ret_logit, ret_norm_g, qk_norm_g, w_branch, w_out, lam_init, need_ctx):
    b, n, _ = h.shape
    shift, scale, gate = mod3
    cshift, cscale, cgate = mod3_c
    pl = project(rms_norm(h, g_pre) * (1 + scale) + shift, w_in, PROJ_NAMES)
    pc = project(rms_norm(hc, g_pre) * (1 + cscale) + cshift, w_in, PROJ_NAMES if need_ctx else KV_NAMES)
    cos, sin = axial_rope(n, ROPE_DIM)
    rope = lambda t: apply_rope(t, cos, sin)
    cat = lambda t_lat, t_ctx: jnp.concatenate([t_lat, t_ctx], axis=-2)
    flip = lambda t: t[:, :, ::-1]

    lq1, lk1, lq2, lk2 = diff_lambda.astype(jnp.float32)
    lam = jnp.exp(jnp.sum(lq1 * lk1)) - jnp.exp(jnp.sum(lq2 * lk2)) + lam_init
    ka_c, va_c = diff_heads(pc['a_k']), heads(pc['a_v'], DA_HEADS, DA_DV)
    diff_out = lambda o: merge_heads(rms_norm(o, diff_norm_g) * (1.0 - lam_init))
    oa = diff_out(diff_attention(rope(diff_heads(pl['a_q'])),
                                 cat(rope(diff_heads(pl['a_k'])), ka_c),
                                 cat(heads(pl['a_v'], DA_HEADS, DA_DV), va_c), lam))

    lg = jax.nn.log_sigmoid(ret_logit.astype(jnp.float32))
    kb_c, vb_c = heads(pc['b_k'], RET_HEADS, RET_DK), heads(pc['b_v'], RET_HEADS, RET_DV)
    if need_ctx:
        zero = jnp.zeros((b, RET_HEADS, RET_DK, RET_DV), jnp.float32)
        qb_c = heads(pc['b_q'], RET_HEADS, RET_DK) * RET_DK ** -0.5
        o_cf, s_f = retention_chunks(qb_c, kb_c, vb_c, lg[0], zero)
        o_cb, s_b = retention_chunks(flip(qb_c), flip(kb_c), flip(vb_c), lg[1], zero)
    else:
        s_f = retention_state(kb_c, vb_c, lg[0])
        s_b = retention_state(flip(kb_c), flip(vb_c), lg[1])
    qb = rope(heads(pl['b_q'], RET_HEADS, RET_DK)) * RET_DK ** -0.5
    kb = rope(heads(pl['b_k'], RET_HEADS, RET_DK))
    vb = heads(pl['b_v'], RET_HEADS, RET_DV)
    o_f, _ = retention_chunks(qb, kb, vb, lg[0], s_f)
    o_b, _ = retention_chunks(flip(qb), flip(kb), flip(vb), lg[1], s_b)
    ret_out = lambda o, g: merge_heads(rms_norm(o.astype(h.dtype), ret_norm_g)) * jax.nn.silu(g)
    ob = ret_out(o_f + flip(o_b), pl['b_g'])

    kc_c = rms_norm(heads(pc['c_k'], GQA_KV, GQA_DH), qk_norm_g[1])
    vc_c = heads(pc['c_v'], GQA_KV, GQA_DH)
    def gqa_out(o):
        bb, gg, rr, nn, dd = o.shape
        return o.transpose(0, 3, 1, 2, 4).reshape(bb, nn, gg * rr * dd)
    oc = gqa_out(gqa_attention(rope(rms_norm(gqa_q_heads(pl['c_q']), qk_norm_g[0])),
                               cat(rope(rms_norm(heads(pl['c_k'], GQA_KV, GQA_DH), qk_norm_g[1])), kc_c),
                               cat(heads(pl['c_v'], GQA_KV, GQA_DH), vc_c)))

    out = merge_branches((oa, ob, oc), pl['gate'], b_gate, w_branch, w_out)
    h = h + gate * rms_norm(out, g_post)
    if not need_ctx:
        return h, None

    oa_c = diff_out(diff_attention(diff_heads(pc['a_q']), ka_c, va_c, lam))
    ob_c = ret_out(o_cf + flip(o_cb), pc['b_g'])
    oc_c = gqa_out(gqa_attention(rms_norm(gqa_q_heads(pc['c_q']), qk_norm_g[0]), kc_c, vc_c))
    out_c = merge_branches((oa_c, ob_c, oc_c), pc['gate'], b_gate, w_branch, w_out)
    hc = hc + cgate * rms_norm(out_c, g_post)
    return h, hc


def setup_inputs(seed: int = 0) -> dict:
    key = jax.random.key(seed)
    ks = jax.random.split(key, 18)
    f32 = jnp.float32
    nrm = lambda k, shape, s: jax.random.normal(k, shape, f32) * s
    gamma0 = 1.0 - 2.0 ** (-5.0 - jnp.arange(RET_HEADS, dtype=f32))
    return {
        'x': nrm(ks[0], (BATCH, SEQ, D_MODEL), 1.0),
        'c': nrm(ks[1], (BATCH, D_MODEL), 1.0),
        'ctx': nrm(ks[2], (BATCH, CTX_LEN, D_MODEL), 1.0),
        'c_ctx': nrm(ks[3], (D_MODEL,), 1.0),
        'w_mod': nrm(ks[4], (DEPTH, D_MODEL, 3 * N_SUB * D_MODEL), 0.5 * D_MODEL ** -0.5),
        'b_mod': nrm(ks[5], (DEPTH, 3 * N_SUB * D_MODEL), 0.02),
        'norm_g': 1.0 + nrm(ks[6], (DEPTH, 2 * N_SUB, D_MODEL), 0.05),
        'w_ffn_in': nrm(ks[7], (DEPTH, 2, D_MODEL, 2 * D_FF), D_MODEL ** -0.5),
        'w_ffn_out': nrm(ks[8], (DEPTH, 2, D_FF, D_MODEL), D_FF ** -0.5),
        'w_in': nrm(ks[9], (DEPTH, D_MODEL, IN_COLS), D_MODEL ** -0.5),
        'b_gate': nrm(ks[10], (DEPTH, N_BRANCH * D_MODEL), 0.02),
        'diff_lambda': nrm(ks[11], (DEPTH, 4, DA_DH), 0.1),
        'diff_norm_g': 1.0 + nrm(ks[12], (DEPTH, DA_DV), 0.05),
        'ret_decay_logit': jnp.log(gamma0 / (1.0 - gamma0))[None, None, :] + nrm(ks[13], (DEPTH, 2, RET_HEADS), 0.1),
        'ret_norm_g': 1.0 + nrm(ks[14], (DEPTH, RET_DV), 0.05),
        'qk_norm_g': 1.0 + nrm(ks[15], (DEPTH, 2, GQA_DH), 0.05),
        'w_branch': nrm(ks[16], (DEPTH, N_BRANCH, BRANCH_W, D_MODEL), BRANCH_W ** -0.5),
        'w_out': nrm(ks[17], (DEPTH, D_MODEL, D_MODEL), D_MODEL ** -0.5),
    }


def reference(x, c, ctx, c_ctx, w_mod, b_mod, norm_g, w_ffn_in, w_ffn_out, w_in, b_gate,
              diff_lambda, diff_norm_g, ret_decay_logit, ret_norm_g, qk_norm_g, w_branch, w_out):
    h, hc = x, ctx
    for l in range(DEPTH):
        last = l == DEPTH - 1
        mod = (jax.nn.silu(c) @ w_mod[l] + b_mod[l]).reshape(c.shape[0], 1, N_SUB, 3, D_MODEL)
        mod_c = (jax.nn.silu(c_ctx) @ w_mod[l] + b_mod[l]).reshape(1, 1, N_SUB, 3, D_MODEL)
        lam_init = 0.8 - 0.6 * math.exp(-0.3 * l)
        h = ffn_sublayer(h, sub_mod(mod, 0), norm_g[l, 0], norm_g[l, 1], w_ffn_in[l, 0], w_ffn_out[l, 0])
        hc = ffn_sublayer(hc, sub_mod(mod_c, 0), norm_g[l, 0], norm_g[l, 1], w_ffn_in[l, 0], w_ffn_out[l, 0])
        h, hc = mixer_sublayer(h, hc, sub_mod(mod, 1), sub_mod(mod_c, 1), norm_g[l, 2], norm_g[l, 3],
                               w_in[l], b_gate[l], diff_lambda[l], diff_norm_g[l], ret_decay_logit[l],
                               ret_norm_g[l], qk_norm_g[l], w_branch[l], w_out[l], lam_init, not last)
        h = ffn_sublayer(h, sub_mod(mod, 2), norm_g[l, 4], norm_g[l, 5], w_ffn_in[l, 1], w_ffn_out[l, 1])
        if not last:
            hc = ffn_sublayer(hc, sub_mod(mod_c, 2), norm_g[l, 4], norm_g[l, 5], w_ffn_in[l, 1], w_ffn_out[l, 1])
    return h
```

```cpp
#include <hip/hip_runtime.h>
#include <hip/hip_cooperative_groups.h>
#include <cstdio>
#include <cstdint>
namespace cg = cooperative_groups;

#ifndef MK_PER_PHASE
#define MK_PER_PHASE 0
#endif

#define LAS __attribute__((address_space(3)))
typedef unsigned short bf16_t;
typedef short bf16x8 __attribute__((ext_vector_type(8)));
typedef short s16x4 __attribute__((ext_vector_type(4)));
typedef float f32x4 __attribute__((ext_vector_type(4)));
typedef float f32x2 __attribute__((ext_vector_type(2)));
typedef unsigned u32x4 __attribute__((ext_vector_type(4)));
typedef unsigned u32x2 __attribute__((ext_vector_type(2)));
typedef __bf16 bf16v2 __attribute__((ext_vector_type(2)));

constexpr int DM = 1024, NB = 16, SEQ = 2048, CTXL = 256, TPB = 2304, NT = NB * TPB, DFF = 2816, DEPTH = 2;
constexpr int QKVC = 3840, GATEC = 3072, INC = 6912, MODC = 9216;
constexpr float EPS = 1e-6f;
constexpr int NTHREADS = 512;
constexpr int LDS_BYTES = 131072;

constexpr size_t WS_P    = 0;
constexpr size_t WS_G8   = WS_P + (size_t)NT * QKVC * 2;
constexpr size_t WS_Y    = WS_G8 + (size_t)NT * GATEC;
constexpr size_t WS_HC   = WS_Y + (size_t)NT * DM * 2;
constexpr size_t WS_WFI  = WS_HC + (size_t)NB * CTXL * DM * 4;
constexpr size_t WS_WFO  = WS_WFI + (size_t)2 * DFF * DM * 2;
constexpr size_t WS_WMI  = WS_WFO + (size_t)DM * DFF * 2;
constexpr size_t WS_WMB  = WS_WMI + (size_t)INC * DM * 2;
constexpr size_t WS_WMO  = WS_WMB + (size_t)3 * DM * 512 * 2;
constexpr size_t WS_MOD  = WS_WMO + (size_t)DM * DM * 2;
constexpr size_t WS_ROPE = WS_MOD + (size_t)DEPTH * 17 * MODC * 4;
constexpr size_t WS_MISC = WS_ROPE + 64 * 16 * 8;
constexpr size_t WS_END  = WS_MISC + 1024;

struct Params {
    const float *x, *c, *ctx, *c_ctx, *w_mod, *b_mod, *norm_g, *w_ffn_in, *w_ffn_out, *w_in, *b_gate,
                *diff_lambda, *diff_norm_g, *ret_logit, *ret_norm_g, *qk_norm_g, *w_branch, *w_out;
    float* out; unsigned char* ws; int ph_lo, ph_hi;
};

__device__ __forceinline__ int opaque_tid() { int t = (int)threadIdx.x; asm volatile("" : "+v"(t)); return t; }
__device__ __forceinline__ int opaque_bid() { int t = (int)blockIdx.x; asm volatile("" : "+s"(t)); return t; }
__device__ __forceinline__ unsigned pk_bf16(float lo, float hi) { f32x2 v = {lo, hi}; bf16v2 r = __builtin_convertvector(v, bf16v2); return __builtin_bit_cast(unsigned, r); }
__device__ __forceinline__ float bf_lo(unsigned u) { return __uint_as_float(u << 16); }
__device__ __forceinline__ float bf_hi(unsigned u) { return __uint_as_float(u & 0xffff0000u); }
__device__ __forceinline__ float wave_sum(float v) {
    v += __shfl_xor(v, 32); v += __shfl_xor(v, 16); v += __shfl_xor(v, 8); v += __shfl_xor(v, 4); v += __shfl_xor(v, 2); v += __shfl_xor(v, 1); return v; }
__device__ __forceinline__ float fast_sigmoid(float a) { return __frcp_rn(1.0f + __expf(-a)); }
__device__ __forceinline__ float fast_silu(float a) { return a * fast_sigmoid(a); }

namespace pg8 {
constexpr int BM = 256, BK = 64, HALF = 128, HTB = HALF * BK * 2, STAGE_BYTES = 8 * HTB, NXCD = 8, WGM = 8;
__device__ __forceinline__ int lds_byte(int r, int c) { const int st = (r >> 4) * 2 + (c >> 5), rr = r & 15, cc = c & 31, ob = rr * 64 + cc * 2; return st * 1024 + (ob ^ (((ob >> 9) & 1) << 5)); }
__device__ __forceinline__ void stage_rc(int b, int& R, int& C) { const int st = b / 1024, sb = b % 1024, swz = sb ^ (((sb >> 9) & 1) << 5); R = (st >> 1) * 16 + swz / 64; C = (st & 1) * 32 + (swz % 64) / 2; }
__device__ __forceinline__ int perm32(int rho) { const int n = rho >> 4, i = rho & 15; return 8 * (i >> 2) + 4 * n + (i & 3); }

struct Unit { int pm, pn, br, pad; size_t aoff, boff; };
struct Gemm { const bf16_t* A; const bf16_t* Bt; int lda, ldb, K, pad; };

struct Order {
    int nM, nN, nwg, G, c, latent_only, reps, pad;
    size_t a_tile, b_tile, a_rep0, a_rep1, a_rep2, b_rep;
    __device__ __forceinline__ void init(int nM_, int nN_, int latent_only_, int reps_, int lda, int ldb, size_t ar1 = 0, size_t ar2 = 0, size_t brep = 0) {
        nM = nM_; nN = nN_; nwg = nM * nN; G = (int)gridDim.x; c = opaque_bid(); latent_only = latent_only_; reps = reps_; pad = 0;
        a_tile = (size_t)BM * lda * 2; b_tile = (size_t)BM * ldb * 2; a_rep0 = 0; a_rep1 = ar1; a_rep2 = ar2 - ar1; b_rep = brep;
    }
    __device__ __forceinline__ bool next(int i, Unit& u) const {
        int it = i, br = 0;
        if (reps == 3) { it = i / 3; br = i - it * 3; }
        const long L = (long)it * G + c; if (L >= nwg) return false;
        int wgid = (int)L; { const int q = nwg / NXCD, r = nwg % NXCD, xcd = wgid % NXCD, off = wgid / NXCD; wgid = (xcd < r ? xcd * (q + 1) : r * (q + 1) + (xcd - r) * q) + off; }
        const int nig = WGM * nN, gid = wgid / nig, fm = gid * WGM, gsz = (nM - fm) < WGM ? (nM - fm) : WGM;
        const int pmv = fm + ((wgid % nig) % gsz); u.pn = (wgid % nig) / gsz;
        u.pm = latent_only ? (pmv >> 3) * 9 + (pmv & 7) : pmv; u.br = br; u.pad = 0;
        u.aoff = (size_t)u.pm * a_tile + (size_t)(br > 0 ? 1 : 0) * (a_rep1 + (size_t)(br - 1) * a_rep2);
        u.boff = (size_t)u.pn * b_tile + (size_t)br * b_rep;
        return true;
    }
};


struct EpiPlain {
    bf16_t* O; int ldc;
    __device__ __forceinline__ void operator()(const f32x4 (&acc)[2][2][4][2], const Unit& u, int wr, int wc, int fr, int fq) const {
        const int row0 = u.pm * BM + wr * 64 + fr, col0 = u.pn * BM + wc * 32 + 8 * fq;
#pragma unroll
        for (int ai = 0; ai < 2; ++ai)
#pragma unroll
            for (int m = 0; m < 4; ++m) { bf16_t* rowp = O + (size_t)(row0 + ai * HALF + m * 16) * ldc + col0;
#pragma unroll
                for (int bj = 0; bj < 2; ++bj) { const f32x4 v0 = acc[ai][bj][m][0], v1 = acc[ai][bj][m][1];
                    u32x4 w; w.x = pk_bf16(v0[0], v0[1]); w.y = pk_bf16(v0[2], v0[3]); w.z = pk_bf16(v1[0], v1[1]); w.w = pk_bf16(v1[2], v1[3]);
                    *(u32x4*)(rowp + bj * HALF) = w; } }
    }
};
struct EpiSwiglu {
    bf16_t* O;
    __device__ __forceinline__ void operator()(const f32x4 (&acc)[2][2][4][2], const Unit& u, int wr, int wc, int fr, int fq) const {
        const int row0 = u.pm * BM + wr * 64 + fr, col0 = (u.pn * BM + wc * 32 + 8 * fq) >> 1;
#pragma unroll
        for (int ai = 0; ai < 2; ++ai)
#pragma unroll
            for (int m = 0; m < 4; ++m) { bf16_t* rowp = O + (size_t)(row0 + ai * HALF + m * 16) * DFF + col0;
#pragma unroll
                for (int bj = 0; bj < 2; ++bj) { const f32x4 a = acc[ai][bj][m][0], g = acc[ai][bj][m][1];
                    u32x2 w; w.x = pk_bf16(fast_silu(a[0]) * g[0], fast_silu(a[1]) * g[1]); w.y = pk_bf16(fast_silu(a[2]) * g[2], fast_silu(a[3]) * g[3]);
                    *(u32x2*)(rowp + bj * (HALF / 2)) = w; } }
    }
};
struct EpiQkvGate {
    bf16_t* P; unsigned char* G8; const float* bgate;
    __device__ __forceinline__ void operator()(const f32x4 (&acc)[2][2][4][2], const Unit& u, int wr, int wc, int fr, int fq) const {
        const int row0 = u.pm * BM + wr * 64 + fr;
        if (u.pn < 15) {
            const int col0 = u.pn * BM + wc * 32 + 8 * fq;
#pragma unroll
            for (int ai = 0; ai < 2; ++ai)
#pragma unroll
                for (int m = 0; m < 4; ++m) { bf16_t* rowp = P + (size_t)(row0 + ai * HALF + m * 16) * QKVC + col0;
#pragma unroll
                    for (int bj = 0; bj < 2; ++bj) { const f32x4 v0 = acc[ai][bj][m][0], v1 = acc[ai][bj][m][1];
                        u32x4 w; w.x = pk_bf16(v0[0], v0[1]); w.y = pk_bf16(v0[2], v0[3]); w.z = pk_bf16(v1[0], v1[1]); w.w = pk_bf16(v1[2], v1[3]);
                        *(u32x4*)(rowp + bj * HALF) = w; } }
        } else {
            const int col0 = (u.pn - 15) * BM + wc * 32 + 8 * fq;
            f32x4 bv[2][2];
#pragma unroll
            for (int bj = 0; bj < 2; ++bj)
#pragma unroll
                for (int n = 0; n < 2; ++n) bv[bj][n] = *(const f32x4*)(bgate + col0 + bj * HALF + 4 * n);
#pragma unroll
            for (int ai = 0; ai < 2; ++ai)
#pragma unroll
                for (int m = 0; m < 4; ++m) { unsigned char* rowp = G8 + (size_t)(row0 + ai * HALF + m * 16) * GATEC + col0;
#pragma unroll
                    for (int bj = 0; bj < 2; ++bj) { const f32x4 v0 = acc[ai][bj][m][0] + bv[bj][0], v1 = acc[ai][bj][m][1] + bv[bj][1];
                        unsigned q[8];
#pragma unroll
                        for (int j = 0; j < 4; ++j) { q[j] = (unsigned)__float2uint_rn(fast_sigmoid(v0[j]) * 255.0f); q[4 + j] = (unsigned)__float2uint_rn(fast_sigmoid(v1[j]) * 255.0f); }
                        u32x2 w; w.x = q[0] | (q[1] << 8) | (q[2] << 16) | (q[3] << 24); w.y = q[4] | (q[5] << 8) | (q[6] << 16) | (q[7] << 24);
                        *(u32x2*)(rowp + bj * HALF) = w; } }
        }
    }
};
struct EpiMerge {
    bf16_t* O; const unsigned char* G8;
    __device__ __forceinline__ void operator()(const f32x4 (&acc)[2][2][4][2], const Unit& u, int wr, int wc, int fr, int fq) const {
        const int row0 = u.pm * BM + wr * 64 + fr, col0 = u.pn * BM + wc * 32 + 8 * fq;
        const float s = 1.0f / 255.0f;
#pragma unroll
        for (int ai = 0; ai < 2; ++ai)
#pragma unroll
            for (int m = 0; m < 4; ++m) { const size_t r = (size_t)(row0 + ai * HALF + m * 16);
                bf16_t* rowp = O + r * DM + col0; const unsigned char* gp = G8 + r * GATEC + u.br * DM + col0;
#pragma unroll
                for (int bj = 0; bj < 2; ++bj) { const f32x4 v0 = acc[ai][bj][m][0], v1 = acc[ai][bj][m][1];
                    const u32x2 gq = *(const u32x2*)(gp + bj * HALF);
                    float o[8];
                    o[0] = v0[0] * (s * (float)(gq.x & 255u)); o[1] = v0[1] * (s * (float)((gq.x >> 8) & 255u)); o[2] = v0[2] * (s * (float)((gq.x >> 16) & 255u)); o[3] = v0[3] * (s * (float)(gq.x >> 24));
                    o[4] = v1[0] * (s * (float)(gq.y & 255u)); o[5] = v1[1] * (s * (float)((gq.y >> 8) & 255u)); o[6] = v1[2] * (s * (float)((gq.y >> 16) & 255u)); o[7] = v1[3] * (s * (float)(gq.y >> 24));
                    if (u.br > 0) { const u32x4 old = *(const u32x4*)(rowp + bj * HALF);
                        o[0] += bf_lo(old.x); o[1] += bf_hi(old.x); o[2] += bf_lo(old.y); o[3] += bf_hi(old.y); o[4] += bf_lo(old.z); o[5] += bf_hi(old.z); o[6] += bf_lo(old.w); o[7] += bf_hi(old.w); }
                    u32x4 w; w.x = pk_bf16(o[0], o[1]); w.y = pk_bf16(o[2], o[3]); w.z = pk_bf16(o[4], o[5]); w.w = pk_bf16(o[6], o[7]);
                    *(u32x4*)(rowp + bj * HALF) = w; } }
    }
};

template <class Epi>
__device__ __forceinline__ void gemm_phase(LAS unsigned char* lds, const Gemm g, const Order& S, const Epi& E) {
    const int tid = opaque_tid(), wid = __builtin_amdgcn_readfirstlane(tid >> 6), lane = tid & 63, wr = wid >> 2, wc = wid & 3, fr = lane & 15, fq = lane >> 4;
    const int K = g.K, nt = K / BK;
    unsigned voffA[2], voffB[2];
#pragma unroll
    for (int i = 0; i < 2; ++i) { int R, C; stage_rc(tid * 16 + i * 8192, R, C); const int Rb = (R & ~31) + perm32(R & 31);
        voffA[i] = (unsigned)(R * g.lda + C) * 2u; voffB[i] = (unsigned)(Rb * g.ldb + C) * 2u; }
    const size_t kstep = (size_t)(BK * 2);
    const size_t hstepA = (size_t)HALF * g.lda * 2, hstepB = (size_t)HALF * g.ldb * 2;
    const unsigned ldsw = (unsigned)wid * 1024u;
    const int aoff = lds_byte(wr * 64 + fr, fq * 8), boff = lds_byte(wc * 32 + fr, fq * 8);
#define PG8_SA(b, h) (((b) * 2 + (h)) * HTB)
#define PG8_SB(b, h) ((4 + (b) * 2 + (h)) * HTB)
#define PG8_STAGE(bufoff, gbase, voff) do { _Pragma("unroll") for (int _i = 0; _i < 2; ++_i) \
        __builtin_amdgcn_global_load_lds((const unsigned*)((const char*)(gbase) + (voff)[_i]), (LAS unsigned*)(lds + (bufoff) + ldsw + _i * 8192), 16, 0, 0); } while (0)
#define PG8_LDA(dst, b, h) do { _Pragma("unroll") for (int m = 0; m < 4; ++m) _Pragma("unroll") for (int k = 0; k < 2; ++k) dst[m][k] = *(const LAS bf16x8*)(lds + PG8_SA(b, h) + aoff + m * 2048 + k * 1024); } while (0)
#define PG8_LDB(dst, b, h) do { _Pragma("unroll") for (int n = 0; n < 2; ++n) _Pragma("unroll") for (int k = 0; k < 2; ++k) dst[n][k] = *(const LAS bf16x8*)(lds + PG8_SB(b, h) + boff + n * 2048 + k * 1024); } while (0)
#define PG8_MMA(ai, bj, At, Bt) do { __builtin_amdgcn_s_setprio(1); _Pragma("unroll") for (int m = 0; m < 4; ++m) _Pragma("unroll") for (int n = 0; n < 2; ++n) _Pragma("unroll") for (int k = 0; k < 2; ++k) \
        acc[ai][bj][m][n] = __builtin_amdgcn_mfma_f32_16x16x32_bf16(Bt[n][k], At[m][k], acc[ai][bj][m][n], 0, 0, 0); __builtin_amdgcn_s_setprio(0); } while (0)
#define PG8_WAIT_V(n) asm volatile("s_waitcnt vmcnt(" #n ")" ::: "memory")
#define PG8_WAIT_L(n) asm volatile("s_waitcnt lgkmcnt(" #n ")" ::: "memory")
#define PG8_BAR __builtin_amdgcn_s_barrier()
#define PG8_SCHED __builtin_amdgcn_sched_barrier(0)
    Unit cur, nxt; int ui = 0;
    if (!S.next(0, cur)) return;
    f32x4 acc[2][2][4][2];
#pragma unroll
    for (int a = 0; a < 2; ++a)
#pragma unroll
        for (int b = 0; b < 2; ++b)
#pragma unroll
            for (int m = 0; m < 4; ++m)
#pragma unroll
                for (int n = 0; n < 2; ++n) acc[a][b][m][n] = (f32x4){0.f, 0.f, 0.f, 0.f};
    bf16x8 At[4][2], B0[2][2], B1[2][2];
    const char* cA = (const char*)g.A + cur.aoff; const char* cB = (const char*)g.Bt + cur.boff;
    PG8_STAGE(PG8_SB(0, 0), cB, voffB); PG8_STAGE(PG8_SA(0, 0), cA, voffA); PG8_STAGE(PG8_SB(0, 1), cB + hstepB, voffB); PG8_STAGE(PG8_SA(0, 1), cA + hstepA, voffA);
    if (wr == 1) PG8_BAR;
    PG8_WAIT_V(4); PG8_BAR;
    PG8_STAGE(PG8_SB(1, 0), cB + kstep, voffB); PG8_STAGE(PG8_SA(1, 0), cA + kstep, voffA); PG8_STAGE(PG8_SB(1, 1), cB + hstepB + kstep, voffB);
    PG8_WAIT_V(6); PG8_BAR;
    for (;;) {
        const bool has_next = S.next(ui + 1, nxt);
        const char* nA = has_next ? (const char*)g.A + nxt.aoff : cA; const char* nB = has_next ? (const char*)g.Bt + nxt.boff : cB;
        for (int t = 0; t < nt; t += 2) {
            const bool last = (t == nt - 2);
            const char* a1 = cA + (size_t)(t + 1) * kstep;
            const char* a2 = last ? nA : cA + (size_t)(t + 2) * kstep; const char* b2 = last ? nB : cB + (size_t)(t + 2) * kstep;
            const char* a3 = a2 + kstep; const char* b3 = b2 + kstep;
            PG8_LDB(B0, 0, 0); PG8_SCHED; PG8_LDA(At, 0, 0); PG8_STAGE(PG8_SA(1, 1), a1 + hstepA, voffA);
            PG8_WAIT_L(8); PG8_BAR; PG8_WAIT_L(0); PG8_MMA(0, 0, At, B0); PG8_BAR; PG8_SCHED;
            PG8_LDB(B1, 0, 1); PG8_STAGE(PG8_SB(0, 0), b2, voffB);
            PG8_BAR; PG8_WAIT_L(0); PG8_MMA(0, 1, At, B1); PG8_BAR;
            PG8_LDA(At, 0, 1); PG8_STAGE(PG8_SA(0, 0), a2, voffA);
            PG8_BAR; PG8_WAIT_L(0); PG8_MMA(1, 0, At, B0); PG8_BAR; PG8_SCHED;
            PG8_STAGE(PG8_SB(0, 1), b2 + hstepB, voffB);
            PG8_WAIT_V(6); PG8_BAR; PG8_MMA(1, 1, At, B1); PG8_BAR;
            PG8_LDB(B0, 1, 0); PG8_SCHED; PG8_LDA(At, 1, 0); PG8_STAGE(PG8_SA(0, 1), a2 + hstepA, voffA);
            PG8_WAIT_L(8); PG8_BAR; PG8_WAIT_L(0); PG8_MMA(0, 0, At, B0); PG8_BAR; PG8_SCHED;
            PG8_LDB(B1, 1, 1); PG8_STAGE(PG8_SB(1, 0), b3, voffB);
            PG8_BAR; PG8_WAIT_L(0); PG8_MMA(0, 1, At, B1); PG8_BAR;
            PG8_LDA(At, 1, 1); PG8_STAGE(PG8_SA(1, 0), a3, voffA);
            PG8_BAR; PG8_WAIT_L(0); PG8_MMA(1, 0, At, B0); PG8_BAR; PG8_SCHED;
            PG8_STAGE(PG8_SB(1, 1), b3 + hstepB, voffB);
            PG8_WAIT_V(6); PG8_BAR; PG8_MMA(1, 1, At, B1); PG8_BAR;
        }
        E(acc, cur, wr, wc, fr, fq);
        if (!has_next) break;
#pragma unroll
        for (int a = 0; a < 2; ++a)
#pragma unroll
            for (int b = 0; b < 2; ++b)
#pragma unroll
                for (int m = 0; m < 4; ++m)
#pragma unroll
                    for (int n = 0; n < 2; ++n) acc[a][b][m][n] = (f32x4){0.f, 0.f, 0.f, 0.f};
        cur = nxt; cA = nA; cB = nB; ++ui;
    }
    PG8_WAIT_V(0);
    if (wr == 0) PG8_BAR;
    PG8_BAR;
#undef PG8_SA
#undef PG8_SB
#undef PG8_STAGE
#undef PG8_LDA
#undef PG8_LDB
#undef PG8_MMA
#undef PG8_WAIT_V
#undef PG8_WAIT_L
#undef PG8_BAR
#undef PG8_SCHED
}
}

__device__ __forceinline__ void conv_tile(float* lf, const float* __restrict__ src, int ld, bf16_t* dst, int K, int tv, int tk, int map) {
    const int tid = opaque_tid();
    { const int vl = tid & 63, ks = tid >> 6; const int v = tv * 64 + vl;
      const int sc = map ? (((v & 7) < 4) ? ((v >> 3) * 4 + (v & 7)) : (DFF + (v >> 3) * 4 + (v & 7) - 4)) : v;
#pragma unroll
      for (int kk = 0; kk < 8; ++kk) { const int kl = kk * 8 + ks; lf[kl * 65 + vl] = src[(size_t)(tk * 64 + kl) * ld + sc]; } }
    __syncthreads();
    { const int vl = tid >> 3, ch = tid & 7; float f[8];
#pragma unroll
      for (int e = 0; e < 8; ++e) f[e] = lf[(ch * 8 + e) * 65 + vl];
      u32x4 w; w.x = pk_bf16(f[0], f[1]); w.y = pk_bf16(f[2], f[3]); w.z = pk_bf16(f[4], f[5]); w.w = pk_bf16(f[6], f[7]);
      *(u32x4*)(dst + (size_t)(tv * 64 + vl) * K + tk * 64 + ch * 8) = w; }
    __syncthreads();
}
constexpr int CONV_FFN_TILES = 1408 + 704, CONV_MIX_TILES = 1728 + 384 + 256;
__device__ __forceinline__ void conv_ffn(const Params& p, float* lf, int l, int which, int it) {
    if (it < 1408) conv_tile(lf, p.w_ffn_in + (size_t)(l * 2 + which) * DM * 2 * DFF, 2 * DFF, (bf16_t*)(p.ws + WS_WFI), DM, it >> 4, it & 15, 1);
    else { it -= 1408; conv_tile(lf, p.w_ffn_out + (size_t)(l * 2 + which) * DFF * DM, DM, (bf16_t*)(p.ws + WS_WFO), DFF, it / 44, it % 44, 0); }
}
__device__ __forceinline__ void conv_mix(const Params& p, float* lf, int l, int it) {
    if (it < 1728) conv_tile(lf, p.w_in + (size_t)l * DM * INC, INC, (bf16_t*)(p.ws + WS_WMI), DM, it >> 4, it & 15, 0);
    else if (it < 1728 + 384) { const int j = it - 1728, br = j >> 7, jj = j & 127;
        conv_tile(lf, p.w_branch + (size_t)(l * 3 + br) * 512 * DM, DM, (bf16_t*)(p.ws + WS_WMB) + (size_t)br * DM * 512, 512, jj >> 3, jj & 7, 0); }
    else { const int j = it - 2112; conv_tile(lf, p.w_out + (size_t)l * DM * DM, DM, (bf16_t*)(p.ws + WS_WMO), DM, j >> 4, j & 15, 0); }
}

__device__ __forceinline__ void mod_item(const Params& p, float* lf, int it) {
    float* sl = lf;
    float* red = lf + 1024 * 20;
    const int tid = opaque_tid(), lane = tid & 63, w = tid >> 6;
    const int l = it / 144, col0 = (it % 144) * 64;
    for (int idx = tid; idx < 17 * 1024; idx += NTHREADS) { const int r = idx >> 10, k = idx & 1023; const float v = r < 16 ? p.c[r * 1024 + k] : p.c_ctx[k]; sl[k * 20 + r] = v / (1.0f + __expf(-v)); }
    __syncthreads();
    float acc[17];
#pragma unroll
    for (int r = 0; r < 17; ++r) acc[r] = 0.f;
    const float* wp = p.w_mod + ((size_t)l * DM + w * 128) * MODC + col0 + lane;
#pragma unroll 4
    for (int k = 0; k < 128; ++k) {
        const float wv = wp[(size_t)k * MODC];
        const float* sp = sl + (w * 128 + k) * 20;
        const f32x4 s0 = *(const f32x4*)(sp), s1 = *(const f32x4*)(sp + 4), s2 = *(const f32x4*)(sp + 8), s3 = *(const f32x4*)(sp + 12); const float s4 = sp[16];
        acc[0] += s0[0] * wv; acc[1] += s0[1] * wv; acc[2] += s0[2] * wv; acc[3] += s0[3] * wv;
        acc[4] += s1[0] * wv; acc[5] += s1[1] * wv; acc[6] += s1[2] * wv; acc[7] += s1[3] * wv;
        acc[8] += s2[0] * wv; acc[9] += s2[1] * wv; acc[10] += s2[2] * wv; acc[11] += s2[3] * wv;
        acc[12] += s3[0] * wv; acc[13] += s3[1] * wv; acc[14] += s3[2] * wv; acc[15] += s3[3] * wv; acc[16] += s4 * wv;
    }
#pragma unroll
    for (int r = 0; r < 17; ++r) red[(w * 17 + r) * 64 + lane] = acc[r];
    __syncthreads();
    float* mod = (float*)(p.ws + WS_MOD);
    for (int o = tid; o < 17 * 64; o += NTHREADS) { const int r = o >> 6, ln = o & 63; float s = p.b_mod[l * MODC + col0 + ln];
#pragma unroll
        for (int ww = 0; ww < 8; ++ww) s += red[(ww * 17 + r) * 64 + ln];
        mod[((size_t)l * 17 + r) * MODC + col0 + ln] = s; }
    __syncthreads();
}
__device__ __forceinline__ void misc_item(const Params& p) {
    const int tid = opaque_tid();
    f32x2* rope = (f32x2*)(p.ws + WS_ROPE);
    for (int e = tid; e < 1024; e += NTHREADS) { const int pos = e >> 4, f = e & 15;
        const float inv = powf(10000.0f, -(float)f / 16.0f); const float ang = (float)pos * inv;
        double a = (double)ang * 0.15915494309189535; a -= floor(a); const float fr = (float)a;
        rope[e] = (f32x2){__builtin_amdgcn_cosf(fr), __builtin_amdgcn_sinf(fr)}; }
    float* misc = (float*)(p.ws + WS_MISC);
    if (tid < DEPTH) { const int l = tid; const float* dl = p.diff_lambda + l * 256; float s1 = 0.f, s2 = 0.f;
        for (int i = 0; i < 64; ++i) { s1 += dl[i] * dl[64 + i]; s2 += dl[128 + i] * dl[192 + i]; }
        const float lam_init = 0.8f - 0.6f * expf(-0.3f * (float)l);
        misc[l * 16 + 0] = expf(s1) - expf(s2) + lam_init; misc[l * 16 + 1] = lam_init; }
    if (tid >= 64 && tid < 64 + DEPTH * 8) { const int j = tid - 64, l = j >> 3, dh = j & 7;
        const float x = p.ret_logit[l * 8 + dh]; misc[l * 16 + 4 + dh] = -log1pf(expf(-x)) * 1.4426950408889634f; }
}

__device__ __forceinline__ void ephase_rows(const Params& p, bool first, int lp, int sp, float gs, const bf16_t* ysrc, int ln, int sn, bool latent_only) {
    const int tid = opaque_tid(); const int lane = tid & 63, w = tid >> 6;
    const float* mod = (const float*)(p.ws + WS_MOD);
    float* hc = (float*)(p.ws + WS_HC);
    bf16_t* Y = (bf16_t*)(p.ws + WS_Y);
    for (int t = blockIdx.x * 8 + w; t < NT; t += gridDim.x * 8) {
        const int b = t / TPB, n = t - b * TPB; const bool isctx = n >= SEQ;
        if (latent_only && isctx) continue;
        float* hp = isctx ? hc + (size_t)(b * CTXL + n - SEQ) * DM : p.out + (size_t)(b * SEQ + n) * DM;
        const float* hsrc = first ? (isctx ? p.ctx + (size_t)(b * CTXL + n - SEQ) * DM : p.x + (size_t)(b * SEQ + n) * DM) : hp;
        const int mrow = isctx ? 16 : b;
        f32x4 h[4];
#pragma unroll
        for (int i = 0; i < 4; ++i) h[i] = *(const f32x4*)(hsrc + i * 256 + lane * 4);
        if (!first) {
            const float* mp = mod + ((size_t)lp * 17 + mrow) * MODC + sp * 3072 + 2048;
            const float* gpost = p.norm_g + (size_t)(lp * 6 + 2 * sp + 1) * DM;
            f32x4 y[4]; float ss = 0.f;
#pragma unroll
            for (int i = 0; i < 4; ++i) { const u32x2 v = *(const u32x2*)(ysrc + (size_t)t * DM + i * 256 + lane * 4);
                y[i] = (f32x4){bf_lo(v.x), bf_hi(v.x), bf_lo(v.y), bf_hi(v.y)}; ss += y[i][0] * y[i][0] + y[i][1] * y[i][1] + y[i][2] * y[i][2] + y[i][3] * y[i][3]; }
            ss = wave_sum(ss); const float r = rsqrtf(ss * (1.0f / DM) + EPS);
#pragma unroll
            for (int i = 0; i < 4; ++i) { const f32x4 ga = *(const f32x4*)(mp + i * 256 + lane * 4), gp = *(const f32x4*)(gpost + i * 256 + lane * 4);
                h[i] += gs * ga * (y[i] * r * gp); }
        }
#pragma unroll
        for (int i = 0; i < 4; ++i) *(f32x4*)(hp + i * 256 + lane * 4) = h[i];
        if (sn >= 0) {
            float ss = 0.f;
#pragma unroll
            for (int i = 0; i < 4; ++i) ss += h[i][0] * h[i][0] + h[i][1] * h[i][1] + h[i][2] * h[i][2] + h[i][3] * h[i][3];
            ss = wave_sum(ss); const float r = rsqrtf(ss * (1.0f / DM) + EPS);
            const float* mp = mod + ((size_t)ln * 17 + mrow) * MODC + sn * 3072;
            const float* gpre = p.norm_g + (size_t)(ln * 6 + 2 * sn) * DM;
#pragma unroll
            for (int i = 0; i < 4; ++i) { const f32x4 sh = *(const f32x4*)(mp + i * 256 + lane * 4), sc = *(const f32x4*)(mp + 1024 + i * 256 + lane * 4), gp = *(const f32x4*)(gpre + i * 256 + lane * 4);
                const f32x4 o = h[i] * r * gp * (1.0f + sc) + sh;
                u32x2 wv; wv.x = pk_bf16(o[0], o[1]); wv.y = pk_bf16(o[2], o[3]);
                *(u32x2*)(Y + (size_t)t * DM + i * 256 + lane * 4) = wv; }
        }
    }
}

__device__ __forceinline__ void rope_phase(const Params& p, int l) {
    bf16_t* P = (bf16_t*)(p.ws + WS_P);
    const f32x2* rope = (const f32x2*)(p.ws + WS_ROPE);
    const long total = (long)NT * 136;
    const int tid = opaque_tid();
    for (long idx = (long)blockIdx.x * NTHREADS + tid; idx < total; idx += (long)gridDim.x * NTHREADS) {
        const int t = (int)(idx / 136), rem = (int)(idx - (long)t * 136), gi = rem >> 2, j = rem & 3;
        const int n = t % TPB; const bool isctx = n >= SEQ;
        int col;
        if (gi < 8) col = gi * 64; else if (gi < 16) col = 512 + (gi - 8) * 64; else if (gi < 20) col = 1536 + (gi - 16) * 64; else if (gi < 24) col = 1792 + (gi - 20) * 64;
        else if (gi < 32) col = 3072 + (gi - 24) * 64; else col = 3584 + (gi - 32) * 64;
        bf16_t* bp = P + (size_t)t * QKVC + col + j * 8;
        const u32x4 r1 = *(const u32x4*)bp, r2 = *(const u32x4*)(bp + 32);
        float x1[8] = {bf_lo(r1.x), bf_hi(r1.x), bf_lo(r1.y), bf_hi(r1.y), bf_lo(r1.z), bf_hi(r1.z), bf_lo(r1.w), bf_hi(r1.w)};
        float x2[8] = {bf_lo(r2.x), bf_hi(r2.x), bf_lo(r2.y), bf_hi(r2.y), bf_lo(r2.z), bf_hi(r2.z), bf_lo(r2.w), bf_hi(r2.w)};
        if (gi >= 24) {
            float ss = 0.f;
#pragma unroll
            for (int e = 0; e < 8; ++e) ss += x1[e] * x1[e] + x2[e] * x2[e];
            ss += __shfl_xor(ss, 1); ss += __shfl_xor(ss, 2);
            const float r = rsqrtf(ss * (1.0f / 64.0f) + EPS);
            const float* g = p.qk_norm_g + (size_t)(l * 2 + (gi >= 32 ? 1 : 0)) * 64 + j * 8;
#pragma unroll
            for (int e = 0; e < 8; ++e) { x1[e] *= r * g[e]; x2[e] *= r * g[32 + e]; }
        }
        if (!isctx) {
            const int pos = (j < 2) ? (n >> 6) : (n & 63);
            const f32x2* cs = rope + pos * 16 + (j & 1) * 8;
#pragma unroll
            for (int e = 0; e < 8; ++e) { const f32x2 v = cs[e]; const float a = x1[e], bq = x2[e]; x1[e] = a * v.x - bq * v.y; x2[e] = a * v.y + bq * v.x; }
        }
        if (gi >= 24 || !isctx) {
            u32x4 w1, w2;
            w1.x = pk_bf16(x1[0], x1[1]); w1.y = pk_bf16(x1[2], x1[3]); w1.z = pk_bf16(x1[4], x1[5]); w1.w = pk_bf16(x1[6], x1[7]);
            w2.x = pk_bf16(x2[0], x2[1]); w2.y = pk_bf16(x2[2], x2[3]); w2.z = pk_bf16(x2[4], x2[5]); w2.w = pk_bf16(x2[6], x2[7]);
            *(u32x4*)bp = w1; *(u32x4*)(bp + 32) = w2;
        }
    }
}

template <int KIND>
__device__ __forceinline__ void attn_item(unsigned char* lds, bf16_t* P, const Params& p, int l, int b, int head, int qb, int isctx) {
    constexpr int KW = (KIND == 0) ? 128 : 64, DV = (KIND == 2) ? 64 : 128, NDB = DV / 16;
    constexpr int KSTR = KW * 2 + 16, VSTR = DV * 2 + 32, KBYTES = 64 * KSTR, VBYTES = 64 * VSTR;
    constexpr int KCH = KW / 64, VCH = DV / 64;
    const int tid = opaque_tid(), lane = tid & 63, w = tid >> 6, lq = lane & 15, g = lane >> 4;
    const float* misc = (const float*)(p.ws + WS_MISC) + l * 16;
    const int comp = (KIND == 0) ? (w >> 2) : 0;
    const int qn0 = (KIND == 0) ? qb * 128 + (w & 3) * 32 : qb * 256 + w * 32;
    const size_t rowbase = (size_t)b * TPB + (isctx ? SEQ : 0);
    const int qcol = (KIND == 0) ? head * 128 + comp * 64 : (KIND == 1) ? 1536 + head * 64 : 3072 + head * 64;
    const int kcol = (KIND == 0) ? 512 + head * 128 : (KIND == 1) ? 1792 + head * 64 : 3584 + (head >> 2) * 64;
    const int vcol = (KIND == 0) ? 1024 + head * 128 : (KIND == 1) ? 2048 + head * 128 : 3712 + (head >> 2) * 64;
    const int kt0 = isctx ? 32 : 0, nkt = isctx ? 4 : 36;
    const size_t keyrow0 = (size_t)b * TPB + (size_t)kt0 * 64;

    bf16x8 qf[2][2];
#pragma unroll
    for (int qs = 0; qs < 2; ++qs)
#pragma unroll
        for (int ks = 0; ks < 2; ++ks) qf[qs][ks] = *(const bf16x8*)(P + (rowbase + qn0 + qs * 16 + lq) * QKVC + qcol + ks * 32 + g * 8);

    int qpf[2], qpb[2]; float lf2 = 0.f, lb2 = 0.f;
    if (KIND == 1) {
#pragma unroll
        for (int qs = 0; qs < 2; ++qs) { const int qi = qn0 + qs * 16 + lq; qpf[qs] = isctx ? qi : qi + CTXL; qpb[qs] = isctx ? SEQ + qi : qi; }
        lf2 = misc[4 + head]; lb2 = misc[8 + head];
    }

    f32x4 O[NDB][2];
#pragma unroll
    for (int db = 0; db < NDB; ++db) { O[db][0] = (f32x4){0.f, 0.f, 0.f, 0.f}; O[db][1] = (f32x4){0.f, 0.f, 0.f, 0.f}; }
    float mrun[2] = {-1e30f, -1e30f}, lrun[2] = {0.f, 0.f};

    u32x4 kreg[KCH], vreg[VCH];
    int krow[KCH], kcc[KCH], vrow[VCH], vcc[VCH];
#pragma unroll
    for (int i = 0; i < KCH; ++i) { const int id = tid + i * NTHREADS; krow[i] = id / (KW / 8); kcc[i] = id % (KW / 8); }
#pragma unroll
    for (int i = 0; i < VCH; ++i) { const int id = tid + i * NTHREADS; vrow[i] = id / (DV / 8); vcc[i] = id % (DV / 8); }
#define ATT_LOAD(t) do { const size_t r0 = keyrow0 + (size_t)(t) * 64; \
        _Pragma("unroll") for (int i = 0; i < KCH; ++i) kreg[i] = *(const u32x4*)(P + (r0 + krow[i]) * QKVC + kcol + kcc[i] * 8); \
        _Pragma("unroll") for (int i = 0; i < VCH; ++i) vreg[i] = *(const u32x4*)(P + (r0 + vrow[i]) * QKVC + vcol + vcc[i] * 8); } while (0)
#define ATT_STORE(buf) do { unsigned char* kb_ = lds + (buf) * KBYTES; unsigned char* vb_ = lds + 2 * KBYTES + (buf) * VBYTES; \
        _Pragma("unroll") for (int i = 0; i < KCH; ++i) *(u32x4*)(kb_ + krow[i] * KSTR + kcc[i] * 16) = kreg[i]; \
        _Pragma("unroll") for (int i = 0; i < VCH; ++i) *(u32x4*)(vb_ + vrow[i] * VSTR + vcc[i] * 16) = vreg[i]; } while (0)

    ATT_LOAD(0); ATT_STORE(0);
    __syncthreads();
    const unsigned lds_base = (unsigned)(uintptr_t)(LAS unsigned char*)lds;
    const float csc = 0.125f * 1.4426950408889634f;
    for (int t = 0; t < nkt; ++t) {
        const int buf = t & 1;
        if (t + 1 < nkt) ATT_LOAD(t + 1);
        const unsigned char* Kb = lds + buf * KBYTES;
        f32x4 s[4][2];
#pragma unroll
        for (int kb = 0; kb < 4; ++kb) {
            const bf16x8 kf0 = *(const bf16x8*)(Kb + (kb * 16 + lq) * KSTR + comp * 128 + g * 16);
            const bf16x8 kf1 = *(const bf16x8*)(Kb + (kb * 16 + lq) * KSTR + comp * 128 + 64 + g * 16);
#pragma unroll
            for (int qs = 0; qs < 2; ++qs) {
                f32x4 a = (f32x4){0.f, 0.f, 0.f, 0.f};
                a = __builtin_amdgcn_mfma_f32_16x16x32_bf16(kf0, qf[qs][0], a, 0, 0, 0);
                a = __builtin_amdgcn_mfma_f32_16x16x32_bf16(kf1, qf[qs][1], a, 0, 0, 0);
                s[kb][qs] = a;
            }
        }
        bf16x8 pf[2][2];
#pragma unroll
        for (int qs = 0; qs < 2; ++qs) {
            if (KIND == 1) {
                const int kk0 = (kt0 + t) * 64 + 4 * g;
#pragma unroll
                for (int kb = 0; kb < 4; ++kb)
#pragma unroll
                    for (int r = 0; r < 4; ++r) { const int kk = kk0 + kb * 16 + r; const int pfk = kk < SEQ ? kk + CTXL : kk - SEQ;
                        const int d1 = qpf[qs] - pfk, d2 = kk - qpb[qs];
                        const float w1 = d1 >= 0 ? __builtin_amdgcn_exp2f(lf2 * (float)d1) : 0.f, w2 = d2 >= 0 ? __builtin_amdgcn_exp2f(lb2 * (float)d2) : 0.f;
                        s[kb][qs][r] = s[kb][qs][r] * 0.125f * (w1 + w2); }
            } else {
                float mx = s[0][qs][0];
#pragma unroll
                for (int kb = 0; kb < 4; ++kb)
#pragma unroll
                    for (int r = 0; r < 4; ++r) mx = fmaxf(mx, s[kb][qs][r]);
                mx = fmaxf(mx, __shfl_xor(mx, 16)); mx = fmaxf(mx, __shfl_xor(mx, 32));
                const float mnew = fmaxf(mrun[qs], mx * csc);
                const float alpha = __builtin_amdgcn_exp2f(mrun[qs] - mnew);
                mrun[qs] = mnew;
                float ps = 0.f;
#pragma unroll
                for (int kb = 0; kb < 4; ++kb)
#pragma unroll
                    for (int r = 0; r < 4; ++r) { const float pv = __builtin_amdgcn_exp2f(s[kb][qs][r] * csc - mnew); s[kb][qs][r] = pv; ps += pv; }
                lrun[qs] = lrun[qs] * alpha + ps;
#pragma unroll
                for (int db = 0; db < NDB; ++db) O[db][qs] *= alpha;
            }
#pragma unroll
            for (int j = 0; j < 2; ++j) {
                u32x4 pk; pk.x = pk_bf16(s[2 * j][qs][0], s[2 * j][qs][1]); pk.y = pk_bf16(s[2 * j][qs][2], s[2 * j][qs][3]);
                pk.z = pk_bf16(s[2 * j + 1][qs][0], s[2 * j + 1][qs][1]); pk.w = pk_bf16(s[2 * j + 1][qs][2], s[2 * j + 1][qs][3]);
                pf[qs][j] = __builtin_bit_cast(bf16x8, pk);
            }
        }
        const unsigned vaddr = lds_base + 2 * KBYTES + buf * VBYTES + (4 * g + (lq >> 2)) * VSTR + (lq & 3) * 8;
#pragma unroll
        for (int db = 0; db < NDB; ++db) {
            s16x4 v00, v01, v10, v11;
            asm volatile("ds_read_b64_tr_b16 %0, %4 offset:%5\n\tds_read_b64_tr_b16 %1, %4 offset:%6\n\tds_read_b64_tr_b16 %2, %4 offset:%7\n\tds_read_b64_tr_b16 %3, %4 offset:%8\n\ts_waitcnt lgkmcnt(0)"
                         : "=&v"(v00), "=&v"(v01), "=&v"(v10), "=&v"(v11)
                         : "v"(vaddr), "i"(db * 32), "i"(db * 32 + 16 * VSTR), "i"(db * 32 + 32 * VSTR), "i"(db * 32 + 48 * VSTR) : "memory");
            const bf16x8 vf0 = __builtin_shufflevector(v00, v01, 0, 1, 2, 3, 4, 5, 6, 7);
            const bf16x8 vf1 = __builtin_shufflevector(v10, v11, 0, 1, 2, 3, 4, 5, 6, 7);
#pragma unroll
            for (int qs = 0; qs < 2; ++qs) {
                O[db][qs] = __builtin_amdgcn_mfma_f32_16x16x32_bf16(vf0, pf[qs][0], O[db][qs], 0, 0, 0);
                O[db][qs] = __builtin_amdgcn_mfma_f32_16x16x32_bf16(vf1, pf[qs][1], O[db][qs], 0, 0, 0);
            }
        }
        if (t + 1 < nkt) ATT_STORE(buf ^ 1);
        __syncthreads();
    }
#undef ATT_LOAD
#undef ATT_STORE
    float linv[2] = {1.f, 1.f};
    if (KIND != 1) {
#pragma unroll
        for (int qs = 0; qs < 2; ++qs) { float lt = lrun[qs]; lt += __shfl_xor(lt, 16); lt += __shfl_xor(lt, 32); linv[qs] = 1.0f / lt; }
    }
    if (KIND == 2) {
#pragma unroll
        for (int qs = 0; qs < 2; ++qs) { bf16_t* op = P + (rowbase + qn0 + qs * 16 + lq) * QKVC + 3072 + head * 64 + 4 * g;
#pragma unroll
            for (int db = 0; db < NDB; ++db) { const f32x4 o = O[db][qs] * linv[qs]; u32x2 wv; wv.x = pk_bf16(o[0], o[1]); wv.y = pk_bf16(o[2], o[3]); *(u32x2*)(op + db * 16) = wv; } }
    } else if (KIND == 1) {
        const float* ng = p.ret_norm_g + l * 128;
#pragma unroll
        for (int qs = 0; qs < 2; ++qs) {
            float ss = 0.f;
#pragma unroll
            for (int db = 0; db < NDB; ++db) { const f32x4 o = O[db][qs]; ss += o[0] * o[0] + o[1] * o[1] + o[2] * o[2] + o[3] * o[3]; }
            ss += __shfl_xor(ss, 16); ss += __shfl_xor(ss, 32);
            const float rn = rsqrtf(ss * (1.0f / 128.0f) + EPS);
            bf16_t* op = P + (rowbase + qn0 + qs * 16 + lq) * QKVC + 2560 + head * 128 + 4 * g;
#pragma unroll
            for (int db = 0; db < NDB; ++db) { const u32x2 gv = *(const u32x2*)(op + db * 16); const f32x4 gn = *(const f32x4*)(ng + db * 16 + 4 * g);
                const f32x4 o = O[db][qs] * rn * gn;
                u32x2 wv; wv.x = pk_bf16(o[0] * fast_silu(bf_lo(gv.x)), o[1] * fast_silu(bf_hi(gv.x))); wv.y = pk_bf16(o[2] * fast_silu(bf_lo(gv.y)), o[3] * fast_silu(bf_hi(gv.y)));
                *(u32x2*)(op + db * 16) = wv; }
        }
    } else {
        float* X = (float*)lds;
        if (comp == 1) {
#pragma unroll
            for (int qs = 0; qs < 2; ++qs)
#pragma unroll
                for (int db = 0; db < NDB; ++db)
#pragma unroll
                    for (int r = 0; r < 4; ++r) X[(((w & 3) * 64) + (qs * NDB + db) * 4 + r) * 64 + lane] = O[db][qs][r] * linv[qs];
        }
        __syncthreads();
        if (comp == 0) {
            const float lam = misc[0], osc = 1.0f - misc[1];
            const float* ng = p.diff_norm_g + l * 128;
#pragma unroll
            for (int qs = 0; qs < 2; ++qs) {
                float ss = 0.f;
#pragma unroll
                for (int db = 0; db < NDB; ++db)
#pragma unroll
                    for (int r = 0; r < 4; ++r) { const float o = O[db][qs][r] * linv[qs] - lam * X[(((w & 3) * 64) + (qs * NDB + db) * 4 + r) * 64 + lane]; O[db][qs][r] = o; ss += o * o; }
                ss += __shfl_xor(ss, 16); ss += __shfl_xor(ss, 32);
                const float rn = rsqrtf(ss * (1.0f / 128.0f) + EPS) * osc;
                bf16_t* op = P + (rowbase + qn0 + qs * 16 + lq) * QKVC + head * 128 + 4 * g;
#pragma unroll
                for (int db = 0; db < NDB; ++db) { const f32x4 gn = *(const f32x4*)(ng + db * 16 + 4 * g); const f32x4 o = O[db][qs] * rn * gn;
                    u32x2 wv; wv.x = pk_bf16(o[0], o[1]); wv.y = pk_bf16(o[2], o[3]); *(u32x2*)(op + db * 16) = wv; }
            }
        }
        __syncthreads();
    }
}

__device__ __forceinline__ void attn_phase(const Params& p, unsigned char* lds, int l) {
    bf16_t* P = (bf16_t*)(p.ws + WS_P);
    const int G = (int)gridDim.x, bx = (int)blockIdx.x;
    const int vcu = (G % 8 == 0) ? (bx % 8) * (G / 8) + bx / 8 : bx;
    const bool last = (l == DEPTH - 1);
    const int nA = last ? 1024 : 1152, nB = last ? 512 : 576, nC = last ? 1024 : 1152;
    int idx = vcu;
    for (; idx < nA; idx += G) {
        const int ic = idx >= 1024, j = idx - 1024;
        attn_item<0>(lds, P, p, l, ic ? j >> 3 : idx >> 6, ic ? (j >> 1) & 3 : (idx >> 4) & 3, ic ? j & 1 : idx & 15, ic);
    }
    for (; idx < nA + nB; idx += G) {
        const int j = idx - nA;
        const int ic = j >= 512, jj = j - 512;
        attn_item<1>(lds, P, p, l, ic ? jj >> 2 : j >> 5, ic ? jj & 3 : (j >> 3) & 3, ic ? 0 : j & 7, ic);
    }
    for (; idx < nA + nB + nC; idx += G) {
        const int j = idx - nA - nB;
        const int ic = j >= 1024, jj = j - 1024;
        attn_item<2>(lds, P, p, l, ic ? jj >> 3 : j >> 6, ic ? jj & 7 : (j >> 3) & 7, ic ? 0 : j & 7, ic);
    }
}

constexpr int NPH = 2 + 12 * DEPTH;

__device__ __forceinline__ void run_phase(const Params& p, unsigned char* lds, int ph) {
    float* lf = (float*)lds;
    LAS unsigned char* ldsl = (LAS unsigned char*)lds;
    bf16_t* P = (bf16_t*)(p.ws + WS_P);
    bf16_t* Y = (bf16_t*)(p.ws + WS_Y);
    unsigned char* G8 = p.ws + WS_G8;
#ifndef PHMASK
#define PHMASK 0xffff
#endif
    if (ph == 0 && (PHMASK & 1)) {
        const int total = 288 + 1 + CONV_FFN_TILES + CONV_MIX_TILES;
        for (int it = blockIdx.x; it < total; it += gridDim.x) {
            if (it < 288) mod_item(p, lf, it);
            else if (it == 288) misc_item(p);
            else if (it < 289 + CONV_FFN_TILES) conv_ffn(p, lf, 0, 0, it - 289);
            else conv_mix(p, lf, 0, it - 289 - CONV_FFN_TILES);
        }
        return;
    }
    if (ph == 0) return;
    if (ph == 1) { if (PHMASK & 2) ephase_rows(p, true, 0, 0, 0.f, Y, 0, 0, false); return; }
    const int l = (ph - 2) / 12, k = (ph - 2) % 12;
    const bool last = (l == DEPTH - 1);
    switch (k) {
    case 0: case 9: if (PHMASK & 4) {
        const int lat = (k == 9 && last) ? 1 : 0;
        pg8::Gemm g{Y, (const bf16_t*)(p.ws + WS_WFI), DM, DM, DM, 0};
        pg8::Order S; S.init(lat ? 128 : 144, 22, lat, 1, DM, DM);
        pg8::EpiSwiglu E{P};
        pg8::gemm_phase<pg8::EpiSwiglu>(ldsl, g, S, E);
    } break;
    case 1: case 7: case 10: if (PHMASK & 8) {
        const int lat = (k != 1 && last) ? 1 : 0;
        pg8::Gemm g; pg8::EpiPlain E;
        if (k == 7) { g = pg8::Gemm{Y, (const bf16_t*)(p.ws + WS_WMO), DM, DM, DM, 0}; E = pg8::EpiPlain{P, DM}; }
        else { g = pg8::Gemm{P, (const bf16_t*)(p.ws + WS_WFO), DFF, DFF, DFF, 0}; E = pg8::EpiPlain{Y, DM}; }
        pg8::Order S; S.init(lat ? 128 : 144, 4, lat, 1, g.lda, g.ldb);
        pg8::gemm_phase<pg8::EpiPlain>(ldsl, g, S, E);
    } break;
    case 2: case 8: case 11: if (PHMASK & 2) {
        if (k == 2) { for (int it = blockIdx.x; it < CONV_FFN_TILES; it += gridDim.x) conv_ffn(p, lf, l, 1, it); }
        else if (k == 8) { if (!last) for (int it = blockIdx.x; it < CONV_MIX_TILES; it += gridDim.x) conv_mix(p, lf, l + 1, it); }
        else { if (!last) for (int it = blockIdx.x; it < CONV_FFN_TILES; it += gridDim.x) conv_ffn(p, lf, l + 1, 0, it); }
        if (k == 2) ephase_rows(p, false, l, 0, 0.5f, Y, l, 1, false);
        else if (k == 8) ephase_rows(p, false, l, 1, 1.0f, P, l, 2, last);
        else ephase_rows(p, false, l, 2, 0.5f, Y, last ? l : l + 1, last ? -1 : 0, last);
    } break;
    case 3: if (PHMASK & 16) {
        pg8::Gemm g{Y, (const bf16_t*)(p.ws + WS_WMI), DM, DM, DM, 0};
        pg8::Order S; S.init(144, 27, 0, 1, DM, DM);
        pg8::EpiQkvGate E{P, G8, p.b_gate + (size_t)l * GATEC};
        pg8::gemm_phase<pg8::EpiQkvGate>(ldsl, g, S, E);
    } break;
    case 4: if (PHMASK & 32) rope_phase(p, l); break;
    case 5: if (PHMASK & 64) attn_phase(p, lds, l); break;
    case 6: if (PHMASK & 128) {
        const int lat = last ? 1 : 0;
        pg8::Gemm g{P, (const bf16_t*)(p.ws + WS_WMB), QKVC, 512, 512, 0};
        pg8::Order S; S.init(lat ? 128 : 144, 4, lat, 3, QKVC, 512, 2560 * 2, 3072 * 2, (size_t)DM * 512 * 2);
        pg8::EpiMerge E{Y, G8};
        pg8::gemm_phase<pg8::EpiMerge>(ldsl, g, S, E);
    } break;
    }
}

__global__ void __launch_bounds__(NTHREADS) mk_fwd(Params p) {
    extern __shared__ __attribute__((aligned(16))) unsigned char lds[];
    for (int ph = p.ph_lo; ph < p.ph_hi; ++ph) {
        run_phase(p, lds, ph);
        if (ph + 1 < p.ph_hi) cg::this_grid().sync();
    }
}

extern "C" void kernel_launch(void* const* d_in, const int* in_sizes, int n_in, void* d_out, int out_size, void* d_ws, size_t ws_size, hipStream_t stream) {
    static int grid = 0;
    if (grid == 0) {
        if (ws_size < WS_END) { fprintf(stderr, "kernel_launch: workspace too small: %zu < %zu\n", ws_size, (size_t)WS_END); grid = -1; return; }
        int dev = 0, cus = 0, per_cu = 0;
        hipGetDevice(&dev);
        hipDeviceGetAttribute(&cus, hipDeviceAttributeMultiprocessorCount, dev);
        if (hipFuncSetAttribute((const void*)mk_fwd, hipFuncAttributeMaxDynamicSharedMemorySize, LDS_BYTES) != hipSuccess) { fprintf(stderr, "kernel_launch: hipFuncSetAttribute failed\n"); grid = -1; return; }
        if (hipOccupancyMaxActiveBlocksPerMultiprocessor(&per_cu, (const void*)mk_fwd, NTHREADS, LDS_BYTES) != hipSuccess || per_cu < 1) { fprintf(stderr, "kernel_launch: occupancy query gave %d\n", per_cu); per_cu = 1; }
        (void)hipGetLastError();
        grid = cus * 1;
        if (grid <= 0) grid = 256;
    }
    if (grid < 0) return;
    Params p{};
    p.x = (const float*)d_in[0]; p.c = (const float*)d_in[1]; p.ctx = (const float*)d_in[2]; p.c_ctx = (const float*)d_in[3];
    p.w_mod = (const float*)d_in[4]; p.b_mod = (const float*)d_in[5]; p.norm_g = (const float*)d_in[6]; p.w_ffn_in = (const float*)d_in[7];
    p.w_ffn_out = (const float*)d_in[8]; p.w_in = (const float*)d_in[9]; p.b_gate = (const float*)d_in[10]; p.diff_lambda = (const float*)d_in[11];
    p.diff_norm_g = (const float*)d_in[12]; p.ret_logit = (const float*)d_in[13]; p.ret_norm_g = (const float*)d_in[14]; p.qk_norm_g = (const float*)d_in[15];
    p.w_branch = (const float*)d_in[16]; p.w_out = (const float*)d_in[17];
    p.out = (float*)d_out; p.ws = (unsigned char*)d_ws;
#if MK_PER_PHASE
    for (int ph = 0; ph < NPH; ++ph) {
        p.ph_lo = ph; p.ph_hi = ph + 1;
        hipLaunchKernelGGL(mk_fwd, dim3(grid), dim3(NTHREADS), LDS_BYTES, stream, p);
    }
#else
    p.ph_lo = 0; p.ph_hi = NPH;
    void* args[] = {&p};
    hipError_t e = hipLaunchCooperativeKernel((const void*)mk_fwd, dim3(grid), dim3(NTHREADS), args, LDS_BYTES, stream);
    if (e != hipSuccess) fprintf(stderr, "cooperative launch failed: %s (grid %d)\n", hipGetErrorString(e), grid);
#endif
}
```

```cpp
#include <hip/hip_runtime.h>
#include <hip/hip_cooperative_groups.h>
#include <cstdio>
#include <cstdint>
namespace cg = cooperative_groups;

#ifndef PROBE_DUP
#define PROBE_DUP 0
#endif
#ifndef MK_PER_PHASE
#define MK_PER_PHASE 0
#endif

#define LAS __attribute__((address_space(3)))
typedef unsigned short bf16_t;
typedef short bf16x8 __attribute__((ext_vector_type(8)));
typedef short s16x4 __attribute__((ext_vector_type(4)));
typedef float f32x4 __attribute__((ext_vector_type(4)));
typedef float f32x2 __attribute__((ext_vector_type(2)));
typedef unsigned u32x4 __attribute__((ext_vector_type(4)));
typedef unsigned u32x2 __attribute__((ext_vector_type(2)));
typedef __bf16 bf16v2 __attribute__((ext_vector_type(2)));

constexpr int DM = 1024, NB = 16, SEQ = 2048, CTXL = 256, TPB = 2304, NT = NB * TPB, DFF = 2816, DEPTH = 2;
constexpr int QKVC = 3840, GATEC = 3072, INC = 6912, MODC = 9216;
constexpr float EPS = 1e-6f;
constexpr int NTHREADS = 512;
constexpr int LDS_MAIN = 131072;
constexpr int LDS_BYTES = LDS_MAIN + 16;

constexpr size_t WS_P    = 0;
constexpr size_t WS_G8   = WS_P + (size_t)NT * QKVC * 2;
constexpr size_t WS_Y    = WS_G8 + (size_t)NT * GATEC;
constexpr size_t WS_HC   = WS_Y + (size_t)NT * DM * 2;
constexpr size_t WS_WFI  = WS_HC + (size_t)NB * CTXL * DM * 4;
constexpr size_t WS_WFO  = WS_WFI + (size_t)2 * DFF * DM * 2;
constexpr size_t WS_WMI  = WS_WFO + (size_t)DM * DFF * 2;
constexpr size_t WS_WMB  = WS_WMI + (size_t)INC * DM * 2;
constexpr size_t WS_WMO  = WS_WMB + (size_t)3 * DM * 512 * 2;
constexpr size_t WS_MOD  = WS_WMO + (size_t)DM * DM * 2;
constexpr size_t WS_ROPE = WS_MOD + (size_t)DEPTH * 17 * MODC * 4;
constexpr size_t WS_MISC = WS_ROPE + 64 * 16 * 8;
constexpr size_t WS_BAR  = WS_MISC + 1024;
constexpr size_t WS_END  = WS_BAR + 16384;

struct Params {
    const float *x, *c, *ctx, *c_ctx, *w_mod, *b_mod, *norm_g, *w_ffn_in, *w_ffn_out, *w_in, *b_gate,
                *diff_lambda, *diff_norm_g, *ret_logit, *ret_norm_g, *qk_norm_g, *w_branch, *w_out;
    float* out; unsigned char* ws; int ph_lo, ph_hi, probe, pad;
};

__device__ __forceinline__ int opaque_tid() { int t = (int)threadIdx.x; asm volatile("" : "+v"(t)); return t; }
__device__ __forceinline__ int opaque_bid() { int t = (int)blockIdx.x; asm volatile("" : "+s"(t)); return t; }
__device__ __forceinline__ unsigned pk_bf16(float lo, float hi) { f32x2 v = {lo, hi}; bf16v2 r = __builtin_convertvector(v, bf16v2); return __builtin_bit_cast(unsigned, r); }
__device__ __forceinline__ float bf_lo(unsigned u) { return __uint_as_float(u << 16); }
__device__ __forceinline__ float bf_hi(unsigned u) { return __uint_as_float(u & 0xffff0000u); }
__device__ __forceinline__ float wave_sum(float v) {
    v += __shfl_xor(v, 32); v += __shfl_xor(v, 16); v += __shfl_xor(v, 8); v += __shfl_xor(v, 4); v += __shfl_xor(v, 2); v += __shfl_xor(v, 1); return v; }
__device__ __forceinline__ float fast_sigmoid(float a) { return __builtin_amdgcn_rcpf(1.0f + __builtin_amdgcn_exp2f(a * -1.4426950408889634f)); }
__device__ __forceinline__ float fast_silu(float a) { return a * fast_sigmoid(a); }

namespace pg8 {
constexpr int BM = 256, BK = 64, HALF = 128, HTB = HALF * BK * 2, STAGE_BYTES = 8 * HTB, NXCD = 8, WGM = 8;
__device__ __forceinline__ int lds_byte(int r, int c) { const int st = (r >> 4) * 2 + (c >> 5), rr = r & 15, cc = c & 31, ob = rr * 64 + cc * 2; return st * 1024 + (ob ^ (((ob >> 9) & 1) << 5)); }
__device__ __forceinline__ void stage_rc(int b, int& R, int& C) { const int st = b / 1024, sb = b % 1024, swz = sb ^ (((sb >> 9) & 1) << 5); R = (st >> 1) * 16 + swz / 64; C = (st & 1) * 32 + (swz % 64) / 2; }
__device__ __forceinline__ int perm32(int rho) { const int n = rho >> 4, i = rho & 15; return 8 * (i >> 2) + 4 * n + (i & 3); }

struct Unit { int pm, pn, br, pad; size_t aoff, boff; };
struct Gemm { const bf16_t* A; const bf16_t* Bt; int lda, ldb, K, pad; };

struct Order {
    int nM, nN, nwg, G, c, latent_only, reps, pad;
    size_t a_tile, b_tile, a_rep0, a_rep1, a_rep2, b_rep;
    __device__ __forceinline__ void init(int nM_, int nN_, int latent_only_, int reps_, int lda, int ldb, size_t ar1 = 0, size_t ar2 = 0, size_t brep = 0) {
        nM = nM_; nN = nN_; nwg = nM * nN; G = (int)gridDim.x; c = opaque_bid(); latent_only = latent_only_; reps = reps_; pad = 0;
        a_tile = (size_t)BM * lda * 2; b_tile = (size_t)BM * ldb * 2; a_rep0 = 0; a_rep1 = ar1; a_rep2 = ar2 - ar1; b_rep = brep;
    }
    __device__ __forceinline__ bool next(int i, Unit& u) const {
        int it = i, br = 0;
        if (reps == 3) { it = i / 3; br = i - it * 3; }
        const long L = (long)it * G + c; if (L >= nwg) return false;
        int wgid = (int)L; { const int q = nwg / NXCD, r = nwg % NXCD, xcd = wgid % NXCD, off = wgid / NXCD; wgid = (xcd < r ? xcd * (q + 1) : r * (q + 1) + (xcd - r) * q) + off; }
        const int nig = WGM * nN, gid = wgid / nig, fm = gid * WGM, gsz = (nM - fm) < WGM ? (nM - fm) : WGM;
        const int pmv = fm + ((wgid % nig) % gsz); u.pn = (wgid % nig) / gsz;
        u.pm = latent_only ? (pmv >> 3) * 9 + (pmv & 7) : pmv; u.br = br; u.pad = 0;
        u.aoff = (size_t)u.pm * a_tile + (size_t)(br > 0 ? 1 : 0) * (a_rep1 + (size_t)(br - 1) * a_rep2);
        u.boff = (size_t)u.pn * b_tile + (size_t)br * b_rep;
        return true;
    }
};


struct EpiPlain {
    bf16_t* O; int ldc;
    __device__ __forceinline__ void operator()(const f32x4 (&acc)[2][2][4][2], const Unit& u, int wr, int wc, int fr, int fq) const {
        const int row0 = u.pm * BM + wr * 64 + fr, col0 = u.pn * BM + wc * 32 + 8 * fq;
#pragma unroll
        for (int ai = 0; ai < 2; ++ai)
#pragma unroll
            for (int m = 0; m < 4; ++m) { bf16_t* rowp = O + (size_t)(row0 + ai * HALF + m * 16) * ldc + col0;
#pragma unroll
                for (int bj = 0; bj < 2; ++bj) { const f32x4 v0 = acc[ai][bj][m][0], v1 = acc[ai][bj][m][1];
                    u32x4 w; w.x = pk_bf16(v0[0], v0[1]); w.y = pk_bf16(v0[2], v0[3]); w.z = pk_bf16(v1[0], v1[1]); w.w = pk_bf16(v1[2], v1[3]);
                    *(u32x4*)(rowp + bj * HALF) = w; } }
    }
};
struct EpiSwiglu {
    bf16_t* O;
    __device__ __forceinline__ void operator()(const f32x4 (&acc)[2][2][4][2], const Unit& u, int wr, int wc, int fr, int fq) const {
        const int row0 = u.pm * BM + wr * 64 + fr, col0 = (u.pn * BM + wc * 32 + 8 * fq) >> 1;
#pragma unroll
        for (int ai = 0; ai < 2; ++ai)
#pragma unroll
            for (int m = 0; m < 4; ++m) { bf16_t* rowp = O + (size_t)(row0 + ai * HALF + m * 16) * DFF + col0;
#pragma unroll
                for (int bj = 0; bj < 2; ++bj) { const f32x4 a = acc[ai][bj][m][0], g = acc[ai][bj][m][1];
                    u32x2 w; w.x = pk_bf16(fast_silu(a[0]) * g[0], fast_silu(a[1]) * g[1]); w.y = pk_bf16(fast_silu(a[2]) * g[2], fast_silu(a[3]) * g[3]);
                    *(u32x2*)(rowp + bj * (HALF / 2)) = w; } }
    }
};
struct EpiQkvGate {
    bf16_t* P; unsigned char* G8; const float* bgate;
    __device__ __forceinline__ void operator()(const f32x4 (&acc)[2][2][4][2], const Unit& u, int wr, int wc, int fr, int fq) const {
        const int row0 = u.pm * BM + wr * 64 + fr;
        if (u.pn < 15) {
            const int col0 = u.pn * BM + wc * 32 + 8 * fq;
#pragma unroll
            for (int ai = 0; ai < 2; ++ai)
#pragma unroll
                for (int m = 0; m < 4; ++m) { bf16_t* rowp = P + (size_t)(row0 + ai * HALF + m * 16) * QKVC + col0;
#pragma unroll
                    for (int bj = 0; bj < 2; ++bj) { const f32x4 v0 = acc[ai][bj][m][0], v1 = acc[ai][bj][m][1];
                        u32x4 w; w.x = pk_bf16(v0[0], v0[1]); w.y = pk_bf16(v0[2], v0[3]); w.z = pk_bf16(v1[0], v1[1]); w.w = pk_bf16(v1[2], v1[3]);
                        *(u32x4*)(rowp + bj * HALF) = w; } }
        } else {
            const int col0 = (u.pn - 15) * BM + wc * 32 + 8 * fq;
            f32x4 bv[2][2];
#pragma unroll
            for (int bj = 0; bj < 2; ++bj)
#pragma unroll
                for (int n = 0; n < 2; ++n) bv[bj][n] = *(const f32x4*)(bgate + col0 + bj * HALF + 4 * n);
#pragma unroll
            for (int ai = 0; ai < 2; ++ai)
#pragma unroll
                for (int m = 0; m < 4; ++m) { unsigned char* rowp = G8 + (size_t)(row0 + ai * HALF + m * 16) * GATEC + col0;
#pragma unroll
                    for (int bj = 0; bj < 2; ++bj) { const f32x4 v0 = acc[ai][bj][m][0] + bv[bj][0], v1 = acc[ai][bj][m][1] + bv[bj][1];
                        unsigned q[8];
#pragma unroll
                        for (int j = 0; j < 4; ++j) { q[j] = (unsigned)__float2uint_rn(fast_sigmoid(v0[j]) * 255.0f); q[4 + j] = (unsigned)__float2uint_rn(fast_sigmoid(v1[j]) * 255.0f); }
                        u32x2 w; w.x = q[0] | (q[1] << 8) | (q[2] << 16) | (q[3] << 24); w.y = q[4] | (q[5] << 8) | (q[6] << 16) | (q[7] << 24);
                        *(u32x2*)(rowp + bj * HALF) = w; } }
        }
    }
};
struct EpiMerge {
    bf16_t* O; const unsigned char* G8;
    __device__ __forceinline__ void operator()(const f32x4 (&acc)[2][2][4][2], const Unit& u, int wr, int wc, int fr, int fq) const {
        const int row0 = u.pm * BM + wr * 64 + fr, col0 = u.pn * BM + wc * 32 + 8 * fq;
        const float s = 1.0f / 255.0f;
#pragma unroll
        for (int ai = 0; ai < 2; ++ai) {
            u32x2 gq[4][2]; u32x4 old[4][2];
#pragma unroll
            for (int m = 0; m < 4; ++m) { const size_t r = (size_t)(row0 + ai * HALF + m * 16);
#pragma unroll
                for (int bj = 0; bj < 2; ++bj) gq[m][bj] = *(const u32x2*)(G8 + r * GATEC + u.br * DM + col0 + bj * HALF); }
            if (u.br > 0) {
#pragma unroll
                for (int m = 0; m < 4; ++m) { const size_t r = (size_t)(row0 + ai * HALF + m * 16);
#pragma unroll
                    for (int bj = 0; bj < 2; ++bj) old[m][bj] = *(const u32x4*)(O + r * DM + col0 + bj * HALF); }
            } else {
#pragma unroll
                for (int m = 0; m < 4; ++m)
#pragma unroll
                    for (int bj = 0; bj < 2; ++bj) old[m][bj] = (u32x4){0u, 0u, 0u, 0u};
            }
#pragma unroll
            for (int m = 0; m < 4; ++m) { const size_t r = (size_t)(row0 + ai * HALF + m * 16);
#pragma unroll
                for (int bj = 0; bj < 2; ++bj) { const f32x4 v0 = acc[ai][bj][m][0], v1 = acc[ai][bj][m][1]; const u32x2 g = gq[m][bj]; const u32x4 od = old[m][bj];
                    float o[8];
                    o[0] = v0[0] * (s * (float)(g.x & 255u)) + bf_lo(od.x); o[1] = v0[1] * (s * (float)((g.x >> 8) & 255u)) + bf_hi(od.x);
                    o[2] = v0[2] * (s * (float)((g.x >> 16) & 255u)) + bf_lo(od.y); o[3] = v0[3] * (s * (float)(g.x >> 24)) + bf_hi(od.y);
                    o[4] = v1[0] * (s * (float)(g.y & 255u)) + bf_lo(od.z); o[5] = v1[1] * (s * (float)((g.y >> 8) & 255u)) + bf_hi(od.z);
                    o[6] = v1[2] * (s * (float)((g.y >> 16) & 255u)) + bf_lo(od.w); o[7] = v1[3] * (s * (float)(g.y >> 24)) + bf_hi(od.w);
                    u32x4 w; w.x = pk_bf16(o[0], o[1]); w.y = pk_bf16(o[2], o[3]); w.z = pk_bf16(o[4], o[5]); w.w = pk_bf16(o[6], o[7]);
                    *(u32x4*)(O + r * DM + col0 + bj * HALF) = w; } }
        }
    }
};

template <class Epi>
__device__ __forceinline__ void gemm_phase(LAS unsigned char* lds, const Gemm g, const Order& S, const Epi& E) {
    const int tid = opaque_tid(), wid = __builtin_amdgcn_readfirstlane(tid >> 6), lane = tid & 63, wr = wid >> 2, wc = wid & 3, fr = lane & 15, fq = lane >> 4;
    const int K = g.K, nt = K / BK;
    unsigned voffA[2], voffB[2];
#pragma unroll
    for (int i = 0; i < 2; ++i) { int R, C; stage_rc(tid * 16 + i * 8192, R, C); const int Rb = (R & ~31) + perm32(R & 31);
        voffA[i] = (unsigned)(R * g.lda + C) * 2u; voffB[i] = (unsigned)(Rb * g.ldb + C) * 2u; }
    const size_t kstep = (size_t)(BK * 2);
    const size_t hstepA = (size_t)HALF * g.lda * 2, hstepB = (size_t)HALF * g.ldb * 2;
    const unsigned ldsw = (unsigned)wid * 1024u;
    const int aoff = lds_byte(wr * 64 + fr, fq * 8), boff = lds_byte(wc * 32 + fr, fq * 8);
#define PG8_SA(b, h) (((b) * 2 + (h)) * HTB)
#define PG8_SB(b, h) ((4 + (b) * 2 + (h)) * HTB)
#define PG8_STAGE(bufoff, gbase, voff) do { _Pragma("unroll") for (int _i = 0; _i < 2; ++_i) \
        __builtin_amdgcn_global_load_lds((const unsigned*)((const char*)(gbase) + (voff)[_i]), (LAS unsigned*)(lds + (bufoff) + ldsw + _i * 8192), 16, 0, 0); } while (0)
#define PG8_LDA(dst, b, h) do { _Pragma("unroll") for (int m = 0; m < 4; ++m) _Pragma("unroll") for (int k = 0; k < 2; ++k) dst[m][k] = *(const LAS bf16x8*)(lds + PG8_SA(b, h) + aoff + m * 2048 + k * 1024); } while (0)
#define PG8_LDB(dst, b, h) do { _Pragma("unroll") for (int n = 0; n < 2; ++n) _Pragma("unroll") for (int k = 0; k < 2; ++k) dst[n][k] = *(const LAS bf16x8*)(lds + PG8_SB(b, h) + boff + n * 2048 + k * 1024); } while (0)
#define PG8_MMA(ai, bj, At, Bt) do { __builtin_amdgcn_s_setprio(1); _Pragma("unroll") for (int m = 0; m < 4; ++m) _Pragma("unroll") for (int n = 0; n < 2; ++n) _Pragma("unroll") for (int k = 0; k < 2; ++k) \
        acc[ai][bj][m][n] = __builtin_amdgcn_mfma_f32_16x16x32_bf16(Bt[n][k], At[m][k], acc[ai][bj][m][n], 0, 0, 0); __builtin_amdgcn_s_setprio(0); } while (0)
#define PG8_WAIT_V(n) asm volatile("s_waitcnt vmcnt(" #n ")" ::: "memory")
#define PG8_WAIT_L(n) asm volatile("s_waitcnt lgkmcnt(" #n ")" ::: "memory")
#define PG8_BAR __builtin_amdgcn_s_barrier()
#define PG8_SCHED __builtin_amdgcn_sched_barrier(0)
    Unit cur, nxt; int ui = 0;
    if (!S.next(0, cur)) return;
    f32x4 acc[2][2][4][2];
#pragma unroll
    for (int a = 0; a < 2; ++a)
#pragma unroll
        for (int b = 0; b < 2; ++b)
#pragma unroll
            for (int m = 0; m < 4; ++m)
#pragma unroll
                for (int n = 0; n < 2; ++n) acc[a][b][m][n] = (f32x4){0.f, 0.f, 0.f, 0.f};
    bf16x8 At[4][2], B0[2][2], B1[2][2];
    const char* cA = (const char*)g.A + cur.aoff; const char* cB = (const char*)g.Bt + cur.boff;
    PG8_STAGE(PG8_SB(0, 0), cB, voffB); PG8_STAGE(PG8_SA(0, 0), cA, voffA); PG8_STAGE(PG8_SB(0, 1), cB + hstepB, voffB); PG8_STAGE(PG8_SA(0, 1), cA + hstepA, voffA);
    if (wr == 1) PG8_BAR;
    PG8_WAIT_V(4); PG8_BAR;
    PG8_STAGE(PG8_SB(1, 0), cB + kstep, voffB); PG8_STAGE(PG8_SA(1, 0), cA + kstep, voffA); PG8_STAGE(PG8_SB(1, 1), cB + hstepB + kstep, voffB);
    PG8_WAIT_V(6); PG8_BAR;
    for (;;) {
        const bool has_next = S.next(ui + 1, nxt);
        const char* nA = has_next ? (const char*)g.A + nxt.aoff : cA; const char* nB = has_next ? (const char*)g.Bt + nxt.boff : cB;
        for (int t = 0; t < nt; t += 2) {
            const bool last = (t == nt - 2);
            const char* a1 = cA + (size_t)(t + 1) * kstep;
            const char* a2 = last ? nA : cA + (size_t)(t + 2) * kstep; const char* b2 = last ? nB : cB + (size_t)(t + 2) * kstep;
            const char* a3 = a2 + kstep; const char* b3 = b2 + kstep;
            PG8_LDB(B0, 0, 0); PG8_SCHED; PG8_LDA(At, 0, 0); PG8_STAGE(PG8_SA(1, 1), a1 + hstepA, voffA);
            PG8_WAIT_L(8); PG8_BAR; PG8_WAIT_L(0); PG8_MMA(0, 0, At, B0); PG8_BAR; PG8_SCHED;
            PG8_LDB(B1, 0, 1); PG8_STAGE(PG8_SB(0, 0), b2, voffB);
            PG8_BAR; PG8_WAIT_L(0); PG8_MMA(0, 1, At, B1); PG8_BAR;
            PG8_LDA(At, 0, 1); PG8_STAGE(PG8_SA(0, 0), a2, voffA);
            PG8_BAR; PG8_WAIT_L(0); PG8_MMA(1, 0, At, B0); PG8_BAR; PG8_SCHED;
            PG8_STAGE(PG8_SB(0, 1), b2 + hstepB, voffB);
            PG8_WAIT_V(6); PG8_BAR; PG8_MMA(1, 1, At, B1); PG8_BAR;
            PG8_LDB(B0, 1, 0); PG8_SCHED; PG8_LDA(At, 1, 0); PG8_STAGE(PG8_SA(0, 1), a2 + hstepA, voffA);
            PG8_WAIT_L(8); PG8_BAR; PG8_WAIT_L(0); PG8_MMA(0, 0, At, B0); PG8_BAR; PG8_SCHED;
            PG8_LDB(B1, 1, 1); PG8_STAGE(PG8_SB(1, 0), b3, voffB);
            PG8_BAR; PG8_WAIT_L(0); PG8_MMA(0, 1, At, B1); PG8_BAR;
            PG8_LDA(At, 1, 1); PG8_STAGE(PG8_SA(1, 0), a3, voffA);
            PG8_BAR; PG8_WAIT_L(0); PG8_MMA(1, 0, At, B0); PG8_BAR; PG8_SCHED;
            PG8_STAGE(PG8_SB(1, 1), b3 + hstepB, voffB);
            PG8_WAIT_V(6); PG8_BAR; PG8_MMA(1, 1, At, B1); PG8_BAR;
        }
        E(acc, cur, wr, wc, fr, fq);
        if (!has_next) break;
#pragma unroll
        for (int a = 0; a < 2; ++a)
#pragma unroll
            for (int b = 0; b < 2; ++b)
#pragma unroll
                for (int m = 0; m < 4; ++m)
#pragma unroll
                    for (int n = 0; n < 2; ++n) acc[a][b][m][n] = (f32x4){0.f, 0.f, 0.f, 0.f};
        cur = nxt; cA = nA; cB = nB; ++ui;
    }
    PG8_WAIT_V(0);
    if (wr == 0) PG8_BAR;
    PG8_BAR;
#undef PG8_SA
#undef PG8_SB
#undef PG8_STAGE
#undef PG8_LDA
#undef PG8_LDB
#undef PG8_MMA
#undef PG8_WAIT_V
#undef PG8_WAIT_L
#undef PG8_BAR
#undef PG8_SCHED
}
}

__device__ __forceinline__ void conv_tile(float* lf, const float* __restrict__ src, int ld, bf16_t* dst, int K, int tv, int tk, int map) {
    const int tid = opaque_tid();
    { const int vl = tid & 63, ks = tid >> 6; const int v = tv * 64 + vl;
      const int sc = map ? (((v & 7) < 4) ? ((v >> 3) * 4 + (v & 7)) : (DFF + (v >> 3) * 4 + (v & 7) - 4)) : v;
#pragma unroll
      for (int kk = 0; kk < 8; ++kk) { const int kl = kk * 8 + ks; lf[kl * 65 + vl] = src[(size_t)(tk * 64 + kl) * ld + sc]; } }
    __syncthreads();
    { const int vl = tid >> 3, ch = tid & 7; float f[8];
#pragma unroll
      for (int e = 0; e < 8; ++e) f[e] = lf[(ch * 8 + e) * 65 + vl];
      u32x4 w; w.x = pk_bf16(f[0], f[1]); w.y = pk_bf16(f[2], f[3]); w.z = pk_bf16(f[4], f[5]); w.w = pk_bf16(f[6], f[7]);
      *(u32x4*)(dst + (size_t)(tv * 64 + vl) * K + tk * 64 + ch * 8) = w; }
    __syncthreads();
}
constexpr int CONV_FFN_TILES = 1408 + 704, CONV_MIX_TILES = 1728 + 384 + 256;
__device__ __forceinline__ void conv_ffn(const Params& p, float* lf, int l, int which, int it) {
    if (it < 1408) conv_tile(lf, p.w_ffn_in + (size_t)(l * 2 + which) * DM * 2 * DFF, 2 * DFF, (bf16_t*)(p.ws + WS_WFI), DM, it >> 4, it & 15, 1);
    else { it -= 1408; conv_tile(lf, p.w_ffn_out + (size_t)(l * 2 + which) * DFF * DM, DM, (bf16_t*)(p.ws + WS_WFO), DFF, it / 44, it % 44, 0); }
}
__device__ __forceinline__ void conv_mix(const Params& p, float* lf, int l, int it) {
    if (it < 1728) conv_tile(lf, p.w_in + (size_t)l * DM * INC, INC, (bf16_t*)(p.ws + WS_WMI), DM, it >> 4, it & 15, 0);
    else if (it < 1728 + 384) { const int j = it - 1728, br = j >> 7, jj = j & 127;
        conv_tile(lf, p.w_branch + (size_t)(l * 3 + br) * 512 * DM, DM, (bf16_t*)(p.ws + WS_WMB) + (size_t)br * DM * 512, 512, jj >> 3, jj & 7, 0); }
    else { const int j = it - 2112; conv_tile(lf, p.w_out + (size_t)l * DM * DM, DM, (bf16_t*)(p.ws + WS_WMO), DM, j >> 4, j & 15, 0); }
}

__device__ __forceinline__ void mod_item(const Params& p, float* lf, int it) {
    float* sl = lf;
    float* red = lf + 1024 * 20;
    const int tid = opaque_tid(), lane = tid & 63, w = tid >> 6;
    const int l = it / 144, col0 = (it % 144) * 64;
    for (int idx = tid; idx < 17 * 1024; idx += NTHREADS) { const int r = idx >> 10, k = idx & 1023; const float v = r < 16 ? p.c[r * 1024 + k] : p.c_ctx[k]; sl[k * 20 + r] = v / (1.0f + __expf(-v)); }
    __syncthreads();
    float acc[17];
#pragma unroll
    for (int r = 0; r < 17; ++r) acc[r] = 0.f;
    const float* wp = p.w_mod + ((size_t)l * DM + w * 128) * MODC + col0 + lane;
#pragma unroll 4
    for (int k = 0; k < 128; ++k) {
        const float wv = wp[(size_t)k * MODC];
        const float* sp = sl + (w * 128 + k) * 20;
        const f32x4 s0 = *(const f32x4*)(sp), s1 = *(const f32x4*)(sp + 4), s2 = *(const f32x4*)(sp + 8), s3 = *(const f32x4*)(sp + 12); const float s4 = sp[16];
        acc[0] += s0[0] * wv; acc[1] += s0[1] * wv; acc[2] += s0[2] * wv; acc[3] += s0[3] * wv;
        acc[4] += s1[0] * wv; acc[5] += s1[1] * wv; acc[6] += s1[2] * wv; acc[7] += s1[3] * wv;
        acc[8] += s2[0] * wv; acc[9] += s2[1] * wv; acc[10] += s2[2] * wv; acc[11] += s2[3] * wv;
        acc[12] += s3[0] * wv; acc[13] += s3[1] * wv; acc[14] += s3[2] * wv; acc[15] += s3[3] * wv; acc[16] += s4 * wv;
    }
#pragma unroll
    for (int r = 0; r < 17; ++r) red[(w * 17 + r) * 64 + lane] = acc[r];
    __syncthreads();
    float* mod = (float*)(p.ws + WS_MOD);
    for (int o = tid; o < 17 * 64; o += NTHREADS) { const int r = o >> 6, ln = o & 63; float s = p.b_mod[l * MODC + col0 + ln];
#pragma unroll
        for (int ww = 0; ww < 8; ++ww) s += red[(ww * 17 + r) * 64 + ln];
        mod[((size_t)l * 17 + r) * MODC + col0 + ln] = s; }
    __syncthreads();
}
__device__ __forceinline__ void misc_item(const Params& p) {
    const int tid = opaque_tid();
    f32x2* rope = (f32x2*)(p.ws + WS_ROPE);
    for (int e = tid; e < 1024; e += NTHREADS) { const int pos = e >> 4, f = e & 15;
        const float inv = powf(10000.0f, -(float)f / 16.0f); const float ang = (float)pos * inv;
        double a = (double)ang * 0.15915494309189535; a -= floor(a); const float fr = (float)a;
        rope[e] = (f32x2){__builtin_amdgcn_cosf(fr), __builtin_amdgcn_sinf(fr)}; }
    float* misc = (float*)(p.ws + WS_MISC);
    if (tid < DEPTH) { const int l = tid; const float* dl = p.diff_lambda + l * 256; float s1 = 0.f, s2 = 0.f;
        for (int i = 0; i < 64; ++i) { s1 += dl[i] * dl[64 + i]; s2 += dl[128 + i] * dl[192 + i]; }
        const float lam_init = 0.8f - 0.6f * expf(-0.3f * (float)l);
        misc[l * 16 + 0] = expf(s1) - expf(s2) + lam_init; misc[l * 16 + 1] = lam_init; }
    if (tid >= 64 && tid < 64 + DEPTH * 8) { const int j = tid - 64, l = j >> 3, dh = j & 7;
        const float x = p.ret_logit[l * 8 + dh]; misc[l * 16 + 4 + dh] = -log1pf(expf(-x)) * 1.4426950408889634f; }
}

__device__ __forceinline__ void ephase_rows(const Params& p, bool first, int lp, int sp, float gs, const bf16_t* ysrc, int ln, int sn, bool latent_only, int dummy) {
    const int tid = opaque_tid(); const int lane = tid & 63, w = tid >> 6;
    const float* mod = (const float*)(p.ws + WS_MOD);
    float* hc = (float*)(p.ws + WS_HC);
    bf16_t* Y = (bf16_t*)(p.ws + WS_Y);
    for (int t = blockIdx.x * 8 + w; t < NT; t += gridDim.x * 8) {
        const int b = t / TPB, n = t - b * TPB; const bool isctx = n >= SEQ;
        if (latent_only && isctx) continue;
        float* hp = isctx ? hc + (size_t)(b * CTXL + n - SEQ) * DM : p.out + (size_t)(b * SEQ + n) * DM;
        const float* hsrc = first ? (isctx ? p.ctx + (size_t)(b * CTXL + n - SEQ) * DM : p.x + (size_t)(b * SEQ + n) * DM) : hp;
        const int mrow = isctx ? 16 : b;
        f32x4 h[4];
#pragma unroll
        for (int i = 0; i < 4; ++i) h[i] = *(const f32x4*)(hsrc + i * 256 + lane * 4);
        if (!first) {
            const float* mp = mod + ((size_t)lp * 17 + mrow) * MODC + sp * 3072 + 2048;
            const float* gpost = p.norm_g + (size_t)(lp * 6 + 2 * sp + 1) * DM;
            f32x4 y[4]; float ss = 0.f;
#pragma unroll
            for (int i = 0; i < 4; ++i) { const u32x2 v = *(const u32x2*)(ysrc + (size_t)t * DM + i * 256 + lane * 4);
                y[i] = (f32x4){bf_lo(v.x), bf_hi(v.x), bf_lo(v.y), bf_hi(v.y)}; ss += y[i][0] * y[i][0] + y[i][1] * y[i][1] + y[i][2] * y[i][2] + y[i][3] * y[i][3]; }
            ss = wave_sum(ss); const float r = rsqrtf(ss * (1.0f / DM) + EPS);
#pragma unroll
            for (int i = 0; i < 4; ++i) { const f32x4 ga = *(const f32x4*)(mp + i * 256 + lane * 4), gp = *(const f32x4*)(gpost + i * 256 + lane * 4);
                h[i] += gs * ga * (y[i] * r * gp); }
        }
#pragma unroll
        for (int i = 0; i < 4; ++i) if (!dummy) *(f32x4*)(hp + i * 256 + lane * 4) = h[i];
        if (sn >= 0) {
            float ss = 0.f;
#pragma unroll
            for (int i = 0; i < 4; ++i) ss += h[i][0] * h[i][0] + h[i][1] * h[i][1] + h[i][2] * h[i][2] + h[i][3] * h[i][3];
            ss = wave_sum(ss); const float r = rsqrtf(ss * (1.0f / DM) + EPS);
            const float* mp = mod + ((size_t)ln * 17 + mrow) * MODC + sn * 3072;
            const float* gpre = p.norm_g + (size_t)(ln * 6 + 2 * sn) * DM;
#pragma unroll
            for (int i = 0; i < 4; ++i) { const f32x4 sh = *(const f32x4*)(mp + i * 256 + lane * 4), sc = *(const f32x4*)(mp + 1024 + i * 256 + lane * 4), gp = *(const f32x4*)(gpre + i * 256 + lane * 4);
                const f32x4 o = h[i] * r * gp * (1.0f + sc) + sh;
                u32x2 wv; wv.x = pk_bf16(o[0], o[1]); wv.y = pk_bf16(o[2], o[3]);
                if (!dummy) *(u32x2*)(Y + (size_t)t * DM + i * 256 + lane * 4) = wv; }
        }
    }
}

__device__ __forceinline__ void rope_phase(const Params& p, int l, int dummy) {
    bf16_t* P = (bf16_t*)(p.ws + WS_P);
    const f32x2* rope = (const f32x2*)(p.ws + WS_ROPE);
    const long total = (long)NT * 136;
    const int tid = opaque_tid();
    for (long idx = (long)blockIdx.x * NTHREADS + tid; idx < total; idx += (long)gridDim.x * NTHREADS) {
        const int t = (int)(idx / 136), rem = (int)(idx - (long)t * 136), gi = rem >> 2, j = rem & 3;
        const int n = t % TPB; const bool isctx = n >= SEQ;
        int col;
        if (gi < 8) col = gi * 64; else if (gi < 16) col = 512 + (gi - 8) * 64; else if (gi < 20) col = 1536 + (gi - 16) * 64; else if (gi < 24) col = 1792 + (gi - 20) * 64;
        else if (gi < 32) col = 3072 + (gi - 24) * 64; else col = 3584 + (gi - 32) * 64;
        bf16_t* bp = P + (size_t)t * QKVC + col + j * 8;
        const u32x4 r1 = *(const u32x4*)bp, r2 = *(const u32x4*)(bp + 32);
        float x1[8] = {bf_lo(r1.x), bf_hi(r1.x), bf_lo(r1.y), bf_hi(r1.y), bf_lo(r1.z), bf_hi(r1.z), bf_lo(r1.w), bf_hi(r1.w)};
        float x2[8] = {bf_lo(r2.x), bf_hi(r2.x), bf_lo(r2.y), bf_hi(r2.y), bf_lo(r2.z), bf_hi(r2.z), bf_lo(r2.w), bf_hi(r2.w)};
        if (gi >= 24) {
            float ss = 0.f;
#pragma unroll
            for (int e = 0; e < 8; ++e) ss += x1[e] * x1[e] + x2[e] * x2[e];
            ss += __shfl_xor(ss, 1); ss += __shfl_xor(ss, 2);
            const float r = rsqrtf(ss * (1.0f / 64.0f) + EPS);
            const float* g = p.qk_norm_g + (size_t)(l * 2 + (gi >= 32 ? 1 : 0)) * 64 + j * 8;
#pragma unroll
            for (int e = 0; e < 8; ++e) { x1[e] *= r * g[e]; x2[e] *= r * g[32 + e]; }
        }
        if (!isctx) {
            const int pos = (j < 2) ? (n >> 6) : (n & 63);
            const f32x2* cs = rope + pos * 16 + (j & 1) * 8;
#pragma unroll
            for (int e = 0; e < 8; ++e) { const f32x2 v = cs[e]; const float a = x1[e], bq = x2[e]; x1[e] = a * v.x - bq * v.y; x2[e] = a * v.y + bq * v.x; }
        }
        if ((gi >= 24 || !isctx) && !dummy) {
            u32x4 w1, w2;
            w1.x = pk_bf16(x1[0], x1[1]); w1.y = pk_bf16(x1[2], x1[3]); w1.z = pk_bf16(x1[4], x1[5]); w1.w = pk_bf16(x1[6], x1[7]);
            w2.x = pk_bf16(x2[0], x2[1]); w2.y = pk_bf16(x2[2], x2[3]); w2.z = pk_bf16(x2[4], x2[5]); w2.w = pk_bf16(x2[6], x2[7]);
            *(u32x4*)bp = w1; *(u32x4*)(bp + 32) = w2;
        }
    }
}

template <int KIND>
__device__ __forceinline__ void attn_item(unsigned char* lds, bf16_t* P, const Params& p, int l, int b, int head, int qb, int isctx, int dummy) {
    constexpr int KW = (KIND == 0) ? 128 : 64, DV = (KIND == 2) ? 64 : 128, NDB = DV / 16;
    constexpr int KSTR = KW * 2 + 16, VSTR = DV * 2 + 32, KBYTES = 64 * KSTR, VBYTES = 64 * VSTR;
    constexpr int KCH = KW / 64, VCH = DV / 64;
    const int tid = opaque_tid(), lane = tid & 63, w = tid >> 6, lq = lane & 15, g = lane >> 4;
    const float* misc = (const float*)(p.ws + WS_MISC) + l * 16;
    const int comp = (KIND == 0) ? (w >> 2) : 0;
    const int qn0 = (KIND == 0) ? qb * 128 + (w & 3) * 32 : qb * 256 + w * 32;
    const size_t rowbase = (size_t)b * TPB + (isctx ? SEQ : 0);
    const int qcol = (KIND == 0) ? head * 128 + comp * 64 : (KIND == 1) ? 1536 + head * 64 : 3072 + head * 64;
    const int kcol = (KIND == 0) ? 512 + head * 128 : (KIND == 1) ? 1792 + head * 64 : 3584 + (head >> 2) * 64;
    const int vcol = (KIND == 0) ? 1024 + head * 128 : (KIND == 1) ? 2048 + head * 128 : 3712 + (head >> 2) * 64;
    const int kt0 = isctx ? 32 : 0, nkt = isctx ? 4 : 36;
    const size_t keyrow0 = (size_t)b * TPB + (size_t)kt0 * 64;

    bf16x8 qf[2][2];
#pragma unroll
    for (int qs = 0; qs < 2; ++qs)
#pragma unroll
        for (int ks = 0; ks < 2; ++ks) qf[qs][ks] = *(const bf16x8*)(P + (rowbase + qn0 + qs * 16 + lq) * QKVC + qcol + ks * 32 + g * 8);

    int qpf[2], qpb[2]; float lf2 = 0.f, lb2 = 0.f;
    if (KIND == 1) {
#pragma unroll
        for (int qs = 0; qs < 2; ++qs) { const int qi = qn0 + qs * 16 + lq; qpf[qs] = isctx ? qi : qi + CTXL; qpb[qs] = isctx ? SEQ + qi : qi; }
        lf2 = misc[4 + head]; lb2 = misc[8 + head];
    }

    f32x4 O[NDB][2];
#pragma unroll
    for (int db = 0; db < NDB; ++db) { O[db][0] = (f32x4){0.f, 0.f, 0.f, 0.f}; O[db][1] = (f32x4){0.f, 0.f, 0.f, 0.f}; }
    float mrun[2] = {-1e30f, -1e30f}, lrun[2] = {0.f, 0.f};

    u32x4 kreg[KCH], vreg[VCH];
    int krow[KCH], kcc[KCH], vrow[VCH], vcc[VCH];
#pragma unroll
    for (int i = 0; i < KCH; ++i) { const int id = tid + i * NTHREADS; krow[i] = id / (KW / 8); kcc[i] = id % (KW / 8); }
#pragma unroll
    for (int i = 0; i < VCH; ++i) { const int id = tid + i * NTHREADS; vrow[i] = id / (DV / 8); vcc[i] = id % (DV / 8); }
#define ATT_LOAD(t) do { const size_t r0 = keyrow0 + (size_t)(t) * 64; \
        _Pragma("unroll") for (int i = 0; i < KCH; ++i) kreg[i] = *(const u32x4*)(P + (r0 + krow[i]) * QKVC + kcol + kcc[i] * 8); \
        _Pragma("unroll") for (int i = 0; i < VCH; ++i) vreg[i] = *(const u32x4*)(P + (r0 + vrow[i]) * QKVC + vcol + vcc[i] * 8); } while (0)
#define ATT_STORE(buf) do { unsigned char* kb_ = lds + (buf) * KBYTES; unsigned char* vb_ = lds + 2 * KBYTES + (buf) * VBYTES; \
        _Pragma("unroll") for (int i = 0; i < KCH; ++i) *(u32x4*)(kb_ + krow[i] * KSTR + kcc[i] * 16) = kreg[i]; \
        _Pragma("unroll") for (int i = 0; i < VCH; ++i) *(u32x4*)(vb_ + vrow[i] * VSTR + vcc[i] * 16) = vreg[i]; } while (0)

    ATT_LOAD(0); ATT_STORE(0);
    __syncthreads();
    const unsigned lds_base = (unsigned)(uintptr_t)(LAS unsigned char*)lds;
    const float csc = 0.125f * 1.4426950408889634f;
    for (int t = 0; t < nkt; ++t) {
        const int buf = t & 1;
        if (t + 1 < nkt) ATT_LOAD(t + 1);
        const unsigned char* Kb = lds + buf * KBYTES;
        f32x4 s[4][2];
#pragma unroll
        for (int kb = 0; kb < 4; ++kb) {
            const bf16x8 kf0 = *(const bf16x8*)(Kb + (kb * 16 + lq) * KSTR + comp * 128 + g * 16);
            const bf16x8 kf1 = *(const bf16x8*)(Kb + (kb * 16 + lq) * KSTR + comp * 128 + 64 + g * 16);
#pragma unroll
            for (int qs = 0; qs < 2; ++qs) {
                f32x4 a = (f32x4){0.f, 0.f, 0.f, 0.f};
                a = __builtin_amdgcn_mfma_f32_16x16x32_bf16(kf0, qf[qs][0], a, 0, 0, 0);
                a = __builtin_amdgcn_mfma_f32_16x16x32_bf16(kf1, qf[qs][1], a, 0, 0, 0);
                s[kb][qs] = a;
            }
        }
        bf16x8 pf[2][2];
#pragma unroll
        for (int qs = 0; qs < 2; ++qs) {
            if (KIND == 1) {
                const int kk0 = (kt0 + t) * 64 + 4 * g;
#pragma unroll
                for (int kb = 0; kb < 4; ++kb)
#pragma unroll
                    for (int r = 0; r < 4; ++r) { const int kk = kk0 + kb * 16 + r; const int pfk = kk < SEQ ? kk + CTXL : kk - SEQ;
                        const int d1 = qpf[qs] - pfk, d2 = kk - qpb[qs];
                        const float w1 = d1 >= 0 ? __builtin_amdgcn_exp2f(lf2 * (float)d1) : 0.f, w2 = d2 >= 0 ? __builtin_amdgcn_exp2f(lb2 * (float)d2) : 0.f;
                        s[kb][qs][r] = s[kb][qs][r] * 0.125f * (w1 + w2); }
            } else {
                float mx = s[0][qs][0];
#pragma unroll
                for (int kb = 0; kb < 4; ++kb)
#pragma unroll
                    for (int r = 0; r < 4; ++r) mx = fmaxf(mx, s[kb][qs][r]);
                mx = fmaxf(mx, __shfl_xor(mx, 16)); mx = fmaxf(mx, __shfl_xor(mx, 32));
                const float mnew = fmaxf(mrun[qs], mx * csc);
                const float alpha = __builtin_amdgcn_exp2f(mrun[qs] - mnew);
                mrun[qs] = mnew;
                float ps = 0.f;
#pragma unroll
                for (int kb = 0; kb < 4; ++kb)
#pragma unroll
                    for (int r = 0; r < 4; ++r) { const float pv = __builtin_amdgcn_exp2f(s[kb][qs][r] * csc - mnew); s[kb][qs][r] = pv; ps += pv; }
                lrun[qs] = lrun[qs] * alpha + ps;
#pragma unroll
                for (int db = 0; db < NDB; ++db) O[db][qs] *= alpha;
            }
#pragma unroll
            for (int j = 0; j < 2; ++j) {
                u32x4 pk; pk.x = pk_bf16(s[2 * j][qs][0], s[2 * j][qs][1]); pk.y = pk_bf16(s[2 * j][qs][2], s[2 * j][qs][3]);
                pk.z = pk_bf16(s[2 * j + 1][qs][0], s[2 * j + 1][qs][1]); pk.w = pk_bf16(s[2 * j + 1][qs][2], s[2 * j + 1][qs][3]);
                pf[qs][j] = __builtin_bit_cast(bf16x8, pk);
            }
        }
        const unsigned vaddr = lds_base + 2 * KBYTES + buf * VBYTES + (4 * g + (lq >> 2)) * VSTR + (lq & 3) * 8;
#pragma unroll
        for (int db = 0; db < NDB; ++db) {
            s16x4 v00, v01, v10, v11;
            asm volatile("ds_read_b64_tr_b16 %0, %4 offset:%5\n\tds_read_b64_tr_b16 %1, %4 offset:%6\n\tds_read_b64_tr_b16 %2, %4 offset:%7\n\tds_read_b64_tr_b16 %3, %4 offset:%8\n\ts_waitcnt lgkmcnt(0)"
                         : "=&v"(v00), "=&v"(v01), "=&v"(v10), "=&v"(v11)
                         : "v"(vaddr), "i"(db * 32), "i"(db * 32 + 16 * VSTR), "i"(db * 32 + 32 * VSTR), "i"(db * 32 + 48 * VSTR) : "memory");
            const bf16x8 vf0 = __builtin_shufflevector(v00, v01, 0, 1, 2, 3, 4, 5, 6, 7);
            const bf16x8 vf1 = __builtin_shufflevector(v10, v11, 0, 1, 2, 3, 4, 5, 6, 7);
#pragma unroll
            for (int qs = 0; qs < 2; ++qs) {
                O[db][qs] = __builtin_amdgcn_mfma_f32_16x16x32_bf16(vf0, pf[qs][0], O[db][qs], 0, 0, 0);
                O[db][qs] = __builtin_amdgcn_mfma_f32_16x16x32_bf16(vf1, pf[qs][1], O[db][qs], 0, 0, 0);
            }
        }
        if (t + 1 < nkt) ATT_STORE(buf ^ 1);
        __syncthreads();
    }
#undef ATT_LOAD
#undef ATT_STORE
    float linv[2] = {1.f, 1.f};
    if (KIND != 1) {
#pragma unroll
        for (int qs = 0; qs < 2; ++qs) { float lt = lrun[qs]; lt += __shfl_xor(lt, 16); lt += __shfl_xor(lt, 32); linv[qs] = 1.0f / lt; }
    }
    if (KIND == 2) {
#pragma unroll
        for (int qs = 0; qs < 2; ++qs) { bf16_t* op = P + (rowbase + qn0 + qs * 16 + lq) * QKVC + 3072 + head * 64 + 4 * g;
#pragma unroll
            for (int db = 0; db < NDB; ++db) { const f32x4 o = O[db][qs] * linv[qs]; u32x2 wv; wv.x = pk_bf16(o[0], o[1]); wv.y = pk_bf16(o[2], o[3]); if (!dummy) *(u32x2*)(op + db * 16) = wv; } }
    } else if (KIND == 1) {
        const float* ng = p.ret_norm_g + l * 128;
#pragma unroll
        for (int qs = 0; qs < 2; ++qs) {
            float ss = 0.f;
#pragma unroll
            for (int db = 0; db < NDB; ++db) { const f32x4 o = O[db][qs]; ss += o[0] * o[0] + o[1] * o[1] + o[2] * o[2] + o[3] * o[3]; }
            ss += __shfl_xor(ss, 16); ss += __shfl_xor(ss, 32);
            const float rn = rsqrtf(ss * (1.0f / 128.0f) + EPS);
            bf16_t* op = P + (rowbase + qn0 + qs * 16 + lq) * QKVC + 2560 + head * 128 + 4 * g;
#pragma unroll
            for (int db = 0; db < NDB; ++db) { const u32x2 gv = *(const u32x2*)(op + db * 16); const f32x4 gn = *(const f32x4*)(ng + db * 16 + 4 * g);
                const f32x4 o = O[db][qs] * rn * gn;
                u32x2 wv; wv.x = pk_bf16(o[0] * fast_silu(bf_lo(gv.x)), o[1] * fast_silu(bf_hi(gv.x))); wv.y = pk_bf16(o[2] * fast_silu(bf_lo(gv.y)), o[3] * fast_silu(bf_hi(gv.y)));
                if (!dummy) *(u32x2*)(op + db * 16) = wv; }
        }
    } else {
        float* X = (float*)lds;
        if (comp == 1) {
#pragma unroll
            for (int qs = 0; qs < 2; ++qs)
#pragma unroll
                for (int db = 0; db < NDB; ++db)
#pragma unroll
                    for (int r = 0; r < 4; ++r) X[(((w & 3) * 64) + (qs * NDB + db) * 4 + r) * 64 + lane] = O[db][qs][r] * linv[qs];
        }
        __syncthreads();
        if (comp == 0) {
            const float lam = misc[0], osc = 1.0f - misc[1];
            const float* ng = p.diff_norm_g + l * 128;
#pragma unroll
            for (int qs = 0; qs < 2; ++qs) {
                float ss = 0.f;
#pragma unroll
                for (int db = 0; db < NDB; ++db)
#pragma unroll
                    for (int r = 0; r < 4; ++r) { const float o = O[db][qs][r] * linv[qs] - lam * X[(((w & 3) * 64) + (qs * NDB + db) * 4 + r) * 64 + lane]; O[db][qs][r] = o; ss += o * o; }
                ss += __shfl_xor(ss, 16); ss += __shfl_xor(ss, 32);
                const float rn = rsqrtf(ss * (1.0f / 128.0f) + EPS) * osc;
                bf16_t* op = P + (rowbase + qn0 + qs * 16 + lq) * QKVC + head * 128 + 4 * g;
#pragma unroll
                for (int db = 0; db < NDB; ++db) { const f32x4 gn = *(const f32x4*)(ng + db * 16 + 4 * g); const f32x4 o = O[db][qs] * rn * gn;
                    u32x2 wv; wv.x = pk_bf16(o[0], o[1]); wv.y = pk_bf16(o[2], o[3]); if (!dummy) *(u32x2*)(op + db * 16) = wv; }
            }
        }
        __syncthreads();
    }
}

__device__ __forceinline__ void attn_phase(const Params& p, unsigned char* lds, int l, int dummy) {
    bf16_t* P = (bf16_t*)(p.ws + WS_P);
    const int G = (int)gridDim.x, bx = (int)blockIdx.x;
    const int vcu = (G % 8 == 0) ? (bx % 8) * (G / 8) + bx / 8 : bx;
    const bool last = (l == DEPTH - 1);
    const int nA = last ? 1024 : 1152, nB = last ? 512 : 576, nC = last ? 1024 : 1152;
    int idx = vcu;
    for (; idx < nA; idx += G) {
        const int ic = idx >= 1024, j = idx - 1024;
        attn_item<0>(lds, P, p, l, ic ? j >> 3 : idx >> 6, ic ? (j >> 1) & 3 : (idx >> 4) & 3, ic ? j & 1 : idx & 15, ic, dummy);
    }
    for (; idx < nA + nB; idx += G) {
        const int j = idx - nA;
        const int ic = j >= 512, jj = j - 512;
        attn_item<1>(lds, P, p, l, ic ? jj >> 2 : j >> 5, ic ? jj & 3 : (j >> 3) & 3, ic ? 0 : j & 7, ic, dummy);
    }
    for (; idx < nA + nB + nC; idx += G) {
        const int j = idx - nA - nB;
        const int ic = j >= 1024, jj = j - 1024;
        attn_item<2>(lds, P, p, l, ic ? jj >> 3 : j >> 6, ic ? jj & 7 : (j >> 3) & 7, ic ? 0 : j & 7, ic, dummy);
    }
}

#define XB_TMO      128
#define XB_XCNT(j)  (256  + 64 * (j))
#define XB_XSUB(j)  (1280 + 64 * (j))
#define XB_XGEN(j)  (2304 + 64 * (j))
#define XB_TOP      3328
#define XB_TOPGEN   3392
#define XCD_BAR_WORDS 3456
#define XB_SPIN_CAP (1u << 18)
__device__ __forceinline__ unsigned xb_ld(unsigned* p)              { return __hip_atomic_load(p, __ATOMIC_RELAXED, __HIP_MEMORY_SCOPE_AGENT); }
__device__ __forceinline__ unsigned xb_add(unsigned* p, unsigned v) { return __hip_atomic_fetch_add(p, v, __ATOMIC_RELAXED, __HIP_MEMORY_SCOPE_AGENT); }
__device__ __forceinline__ unsigned xb_xcc_id() { return (unsigned)__builtin_amdgcn_s_getreg((3 << 11) | 20) & 0xFu; }
#define XB_SPIN(cond, bar) do { unsigned _sp = 0; while (cond) { __builtin_amdgcn_s_sleep(1); \
    if ((++_sp & 255u) == 0u) { if (xb_ld(&(bar)[XB_TMO])) break; if (_sp > XB_SPIN_CAP) { atomicAdd(&(bar)[XB_TMO], 1u); break; } } } } while (0)
struct XcdBarrier { unsigned* bar; unsigned x; volatile LAS unsigned* st; };
__device__ __forceinline__ XcdBarrier xcd_barrier_post(unsigned* bar, volatile LAS unsigned* st) {
    XcdBarrier b; b.bar = bar; b.x = xb_xcc_id(); b.st = st;
    if (threadIdx.x == 0) (void)xb_add(&bar[XB_XCNT(b.x)], 1u);
    return b;
}
__device__ __forceinline__ void xcd_barrier_complete(unsigned* bar, unsigned x, unsigned& nloc, unsigned& nx) {
    const unsigned G = gridDim.x * gridDim.y * gridDim.z;
    unsigned sum, cnt, mine, sp = 0u;
    for (;;) {
        sum = 0u; cnt = 0u; mine = 0u;
#pragma unroll
        for (unsigned j = 0; j < 16; ++j) { const unsigned c = xb_ld(&bar[XB_XCNT(j)]); sum += c; cnt += (c > 0u) ? 1u : 0u; mine = (j == x) ? c : mine; }
        if (sum == G) break;
        __builtin_amdgcn_s_sleep(1);
        if ((++sp & 255u) == 0u) { if (xb_ld(&bar[XB_TMO])) break; if (sp > XB_SPIN_CAP) { atomicAdd(&bar[XB_TMO], 1u); break; } }
    }
    nloc = mine > 0u ? mine : 1u; nx = cnt > 0u ? cnt : 1u;
}
__device__ __forceinline__ void xcd_barrier(const XcdBarrier& b) {
    asm volatile("s_waitcnt vmcnt(0)" ::: "memory");
    __syncthreads();
    if (threadIdx.x == 0) {
        unsigned* bar = b.bar;
        __builtin_amdgcn_s_waitcnt(0);
        unsigned nloc = b.st[0], nx = b.st[1];
        if (nloc == 0u) { xcd_barrier_complete(bar, b.x, nloc, nx); b.st[0] = nloc; b.st[1] = nx; }
        const unsigned old = xb_add(&bar[XB_XSUB(b.x)], 1u);
        const unsigned gen = old / nloc;
        if (old + 1u == (gen + 1u) * nloc) {
            __builtin_amdgcn_fence(__ATOMIC_RELEASE, "agent");
            asm volatile("s_waitcnt vmcnt(0)" ::: "memory");
            const unsigned og = xb_add(&bar[XB_TOP], 1u);
            const unsigned tg = og / nx;
            if (og + 1u == (tg + 1u) * nx) xb_add(&bar[XB_TOPGEN], 1u);
            else XB_SPIN(xb_ld(&bar[XB_TOPGEN]) == tg, bar);
            __builtin_amdgcn_fence(__ATOMIC_ACQUIRE, "agent");
            xb_add(&bar[XB_XGEN(b.x)], 1u);
            asm volatile("s_waitcnt vmcnt(0)" ::: "memory");
        } else {
            XB_SPIN(xb_ld(&bar[XB_XGEN(b.x)]) == gen, bar);
            __builtin_amdgcn_fence(__ATOMIC_ACQUIRE, "agent");
            asm volatile("s_waitcnt vmcnt(0)" ::: "memory");
        }
    }
    __syncthreads();
}

constexpr int NPH = 2 + 12 * DEPTH;

__device__ __forceinline__ void run_phase(const Params& p, unsigned char* lds, int ph, int dummy) {
    float* lf = (float*)lds;
    LAS unsigned char* ldsl = (LAS unsigned char*)lds;
    bf16_t* P = (bf16_t*)(p.ws + WS_P);
    bf16_t* Y = (bf16_t*)(p.ws + WS_Y);
    unsigned char* G8 = p.ws + WS_G8;
#ifndef PHMASK
#define PHMASK 0xffff
#endif
    if (ph == 0 && (PHMASK & 1)) {
        const int total = 288 + 1 + CONV_FFN_TILES + CONV_MIX_TILES;
        for (int it = blockIdx.x; it < total; it += gridDim.x) {
            if (it < 288) mod_item(p, lf, it);
            else if (it == 288) misc_item(p);
            else if (it < 289 + CONV_FFN_TILES) conv_ffn(p, lf, 0, 0, it - 289);
            else conv_mix(p, lf, 0, it - 289 - CONV_FFN_TILES);
        }
        return;
    }
    if (ph == 0) return;
    if (ph == 1) { if (PHMASK & 2) ephase_rows(p, true, 0, 0, 0.f, Y, 0, 0, false, dummy); return; }
    const int l = (ph - 2) / 12, k = (ph - 2) % 12;
    const bool last = (l == DEPTH - 1);
    switch (k) {
    case 0: case 9: if (PHMASK & 4) {
        const int lat = (k == 9 && last) ? 1 : 0;
        pg8::Gemm g{Y, (const bf16_t*)(p.ws + WS_WFI), DM, DM, DM, 0};
        pg8::Order S; S.init(lat ? 128 : 144, 22, lat, 1, DM, DM);
        pg8::EpiSwiglu E{P};
        pg8::gemm_phase<pg8::EpiSwiglu>(ldsl, g, S, E);
    } break;
    case 1: case 7: case 10: if (PHMASK & 8) {
        const int lat = (k != 1 && last) ? 1 : 0;
        pg8::Gemm g; pg8::EpiPlain E;
        if (k == 7) { g = pg8::Gemm{Y, (const bf16_t*)(p.ws + WS_WMO), DM, DM, DM, 0}; E = pg8::EpiPlain{P, DM}; }
        else { g = pg8::Gemm{P, (const bf16_t*)(p.ws + WS_WFO), DFF, DFF, DFF, 0}; E = pg8::EpiPlain{Y, DM}; }
        pg8::Order S; S.init(lat ? 128 : 144, 4, lat, 1, g.lda, g.ldb);
        pg8::gemm_phase<pg8::EpiPlain>(ldsl, g, S, E);
    } break;
    case 2: case 8: case 11: if (PHMASK & 2) {
        if (k == 2) { for (int it = blockIdx.x; it < CONV_FFN_TILES; it += gridDim.x) conv_ffn(p, lf, l, 1, it); }
        else if (k == 8) { if (!last) for (int it = blockIdx.x; it < CONV_MIX_TILES; it += gridDim.x) conv_mix(p, lf, l + 1, it); }
        else { if (!last) for (int it = blockIdx.x; it < CONV_FFN_TILES; it += gridDim.x) conv_ffn(p, lf, l + 1, 0, it); }
        if (k == 2) ephase_rows(p, false, l, 0, 0.5f, Y, l, 1, false, dummy);
        else if (k == 8) ephase_rows(p, false, l, 1, 1.0f, P, l, 2, last, dummy);
        else ephase_rows(p, false, l, 2, 0.5f, Y, last ? l : l + 1, last ? -1 : 0, last, dummy);
    } break;
    case 3: if (PHMASK & 16) {
        pg8::Gemm g{Y, (const bf16_t*)(p.ws + WS_WMI), DM, DM, DM, 0};
        pg8::Order S; S.init(144, 27, 0, 1, DM, DM);
        pg8::EpiQkvGate E{P, G8, p.b_gate + (size_t)l * GATEC};
        pg8::gemm_phase<pg8::EpiQkvGate>(ldsl, g, S, E);
    } break;
    case 4: if (PHMASK & 32) rope_phase(p, l, dummy); break;
    case 5: if (PHMASK & 64) attn_phase(p, lds, l, dummy); break;
    case 6: if (PHMASK & 128) {
        const int lat = last ? 1 : 0;
        pg8::Gemm g{P, (const bf16_t*)(p.ws + WS_WMB), QKVC, 512, 512, 0};
        pg8::Order S; S.init(lat ? 128 : 144, 4, lat, 3, QKVC, 512, 2560 * 2, 3072 * 2, (size_t)DM * 512 * 2);
        pg8::EpiMerge E{Y, G8};
        pg8::gemm_phase<pg8::EpiMerge>(ldsl, g, S, E);
    } break;
    }
}

__global__ void __launch_bounds__(NTHREADS) mk_fwd(Params p) {
    extern __shared__ __attribute__((aligned(16))) unsigned char lds[];
    volatile LAS unsigned* st = (volatile LAS unsigned*)((LAS unsigned char*)lds + LDS_MAIN);
    const bool multi = (p.ph_hi - p.ph_lo) > 1;
    XcdBarrier bar; bar.bar = (unsigned*)(p.ws + WS_BAR); bar.x = 0; bar.st = st;
    if (multi) {
        if (threadIdx.x < 4) st[threadIdx.x] = 0u;
        __syncthreads();
        bar = xcd_barrier_post((unsigned*)(p.ws + WS_BAR), st);
    }
    for (int ph = p.ph_lo; ph < p.ph_hi; ++ph) {
        int nrep = 1;
        if (PROBE_DUP) {
            const int k = ph < 2 ? -1 : (ph - 2) % 12;
            const int kind = ph == 0 ? 1 : (ph == 1 || k == 2 || k == 8 || k == 11) ? 2 : (k == 0 || k == 9) ? 4 : (k == 1 || k == 7 || k == 10) ? 8 : k == 3 ? 16 : k == 4 ? 32 : k == 5 ? 64 : 128;
            if ((PROBE_DUP & kind) && p.probe) nrep = 2;
        }
        for (int rep = 0; rep < nrep; ++rep) run_phase(p, lds, ph, rep + 1 < nrep ? 1 : 0);
        if (ph + 1 < p.ph_hi) {
            if (ph == p.ph_lo) cg::this_grid().sync();
            else xcd_barrier(bar);
            if ((PROBE_DUP & 256) && p.probe) xcd_barrier(bar);
        }
    }
}

extern "C" void kernel_launch(void* const* d_in, const int* in_sizes, int n_in, void* d_out, int out_size, void* d_ws, size_t ws_size, hipStream_t stream) {
    static int grid = 0;
    if (grid == 0) {
        if (ws_size < WS_END) { fprintf(stderr, "kernel_launch: workspace too small: %zu < %zu\n", ws_size, (size_t)WS_END); grid = -1; return; }
        int dev = 0, cus = 0, per_cu = 0;
        hipGetDevice(&dev);
        hipDeviceGetAttribute(&cus, hipDeviceAttributeMultiprocessorCount, dev);
        if (hipFuncSetAttribute((const void*)mk_fwd, hipFuncAttributeMaxDynamicSharedMemorySize, LDS_BYTES) != hipSuccess) { fprintf(stderr, "kernel_launch: hipFuncSetAttribute failed\n"); grid = -1; return; }
        if (hipOccupancyMaxActiveBlocksPerMultiprocessor(&per_cu, (const void*)mk_fwd, NTHREADS, LDS_BYTES) != hipSuccess || per_cu < 1) { fprintf(stderr, "kernel_launch: occupancy query gave %d\n", per_cu); per_cu = 1; }
        (void)hipGetLastError();
        grid = cus * 1;
        if (grid <= 0) grid = 256;
    }
    if (grid < 0) return;
    Params p{};
    p.x = (const float*)d_in[0]; p.c = (const float*)d_in[1]; p.ctx = (const float*)d_in[2]; p.c_ctx = (const float*)d_in[3];
    p.w_mod = (const float*)d_in[4]; p.b_mod = (const float*)d_in[5]; p.norm_g = (const float*)d_in[6]; p.w_ffn_in = (const float*)d_in[7];
    p.w_ffn_out = (const float*)d_in[8]; p.w_in = (const float*)d_in[9]; p.b_gate = (const float*)d_in[10]; p.diff_lambda = (const float*)d_in[11];
    p.diff_norm_g = (const float*)d_in[12]; p.ret_logit = (const float*)d_in[13]; p.ret_norm_g = (const float*)d_in[14]; p.qk_norm_g = (const float*)d_in[15];
    p.w_branch = (const float*)d_in[16]; p.w_out = (const float*)d_in[17];
    p.out = (float*)d_out; p.ws = (unsigned char*)d_ws; p.probe = PROBE_DUP ? 1 : 0;
#if MK_PER_PHASE
    for (int ph = 0; ph < NPH; ++ph) {
        p.ph_lo = ph; p.ph_hi = ph + 1;
        hipLaunchKernelGGL(mk_fwd, dim3(grid), dim3(NTHREADS), LDS_BYTES, stream, p);
    }
#else
    p.ph_lo = 0; p.ph_hi = NPH;
    if (hipMemsetAsync((char*)d_ws + WS_BAR, 0, 16384, stream) != hipSuccess) { fprintf(stderr, "kernel_launch: memset of barrier words failed\n"); return; }
    void* args[] = {&p};
    hipError_t e = hipLaunchCooperativeKernel((const void*)mk_fwd, dim3(grid), dim3(NTHREADS), args, LDS_BYTES, stream);
    if (e != hipSuccess) fprintf(stderr, "cooperative launch failed: %s (grid %d)\n", hipGetErrorString(e), grid);
#endif
}
```

```cpp
#include <hip/hip_runtime.h>
#include <hip/hip_cooperative_groups.h>
#include <cstdio>
#include <cstdint>
namespace cg = cooperative_groups;

#ifndef PROBE_DUP
#define PROBE_DUP 128
#endif
#ifndef MK_PER_PHASE
#define MK_PER_PHASE 0
#endif

#define LAS __attribute__((address_space(3)))
typedef unsigned short bf16_t;
typedef short bf16x8 __attribute__((ext_vector_type(8)));
typedef short s16x4 __attribute__((ext_vector_type(4)));
typedef float f32x4 __attribute__((ext_vector_type(4)));
typedef float f32x2 __attribute__((ext_vector_type(2)));
typedef unsigned u32x4 __attribute__((ext_vector_type(4)));
typedef unsigned u32x2 __attribute__((ext_vector_type(2)));
typedef __bf16 bf16v2 __attribute__((ext_vector_type(2)));

constexpr int DM = 1024, NB = 16, SEQ = 2048, CTXL = 256, TPB = 2304, NT = NB * TPB, DFF = 2816, DEPTH = 2;
constexpr int QKVC = 3840, GATEC = 3072, INC = 6912, MODC = 9216;
constexpr float EPS = 1e-6f;
constexpr int NTHREADS = 512;
constexpr int LDS_MAIN = 131072;
constexpr int LDS_BYTES = LDS_MAIN + 16;

constexpr size_t WS_P    = 0;
constexpr size_t WS_G8   = WS_P + (size_t)NT * QKVC * 2;
constexpr size_t WS_Y    = WS_G8 + (size_t)NT * GATEC;
constexpr size_t WS_HC   = WS_Y + (size_t)NT * DM * 2;
constexpr size_t WS_WFI  = WS_HC + (size_t)NB * CTXL * DM * 4;
constexpr size_t WS_WFO  = WS_WFI + (size_t)2 * DFF * DM * 2;
constexpr size_t WS_WMI  = WS_WFO + (size_t)DM * DFF * 2;
constexpr size_t WS_WMB  = WS_WMI + (size_t)INC * DM * 2;
constexpr size_t WS_WMO  = WS_WMB + (size_t)3 * DM * 512 * 2;
constexpr size_t WS_MOD  = WS_WMO + (size_t)DM * DM * 2;
constexpr size_t WS_ROPE = WS_MOD + (size_t)DEPTH * 17 * MODC * 4;
constexpr size_t WS_MISC = WS_ROPE + 64 * 16 * 8;
constexpr size_t WS_BAR  = WS_MISC + 1024;
constexpr size_t WS_END  = WS_BAR + 16384;

struct Params {
    const float *x, *c, *ctx, *c_ctx, *w_mod, *b_mod, *norm_g, *w_ffn_in, *w_ffn_out, *w_in, *b_gate,
                *diff_lambda, *diff_norm_g, *ret_logit, *ret_norm_g, *qk_norm_g, *w_branch, *w_out;
    float* out; unsigned char* ws; int ph_lo, ph_hi, probe, pad;
};

__device__ __forceinline__ int opaque_tid() { int t = (int)threadIdx.x; asm volatile("" : "+v"(t)); return t; }
__device__ __forceinline__ int opaque_bid() { int t = (int)blockIdx.x; asm volatile("" : "+s"(t)); return t; }
__device__ __forceinline__ unsigned pk_bf16(float lo, float hi) { f32x2 v = {lo, hi}; bf16v2 r = __builtin_convertvector(v, bf16v2); return __builtin_bit_cast(unsigned, r); }
__device__ __forceinline__ float bf_lo(unsigned u) { return __uint_as_float(u << 16); }
__device__ __forceinline__ float bf_hi(unsigned u) { return __uint_as_float(u & 0xffff0000u); }
__device__ __forceinline__ float wave_sum(float v) {
    v += __shfl_xor(v, 32); v += __shfl_xor(v, 16); v += __shfl_xor(v, 8); v += __shfl_xor(v, 4); v += __shfl_xor(v, 2); v += __shfl_xor(v, 1); return v; }
__device__ __forceinline__ float fast_sigmoid(float a) { return __builtin_amdgcn_rcpf(1.0f + __builtin_amdgcn_exp2f(a * -1.4426950408889634f)); }
__device__ __forceinline__ float fast_silu(float a) { return a * fast_sigmoid(a); }

namespace pg8 {
constexpr int BM = 256, BK = 64, HALF = 128, HTB = HALF * BK * 2, STAGE_BYTES = 8 * HTB, NXCD = 8, WGM = 8;
__device__ __forceinline__ int lds_byte(int r, int c) { const int st = (r >> 4) * 2 + (c >> 5), rr = r & 15, cc = c & 31, ob = rr * 64 + cc * 2; return st * 1024 + (ob ^ (((ob >> 9) & 1) << 5)); }
__device__ __forceinline__ void stage_rc(int b, int& R, int& C) { const int st = b / 1024, sb = b % 1024, swz = sb ^ (((sb >> 9) & 1) << 5); R = (st >> 1) * 16 + swz / 64; C = (st & 1) * 32 + (swz % 64) / 2; }
__device__ __forceinline__ int perm32(int rho) { const int n = rho >> 4, i = rho & 15; return 8 * (i >> 2) + 4 * n + (i & 3); }

struct Unit { int pm, pn, br, pad; size_t aoff, boff; };
struct Gemm { const bf16_t* A; const bf16_t* Bt; int lda, ldb, K, pad; };

struct Order {
    int nM, nN, nwg, G, c, latent_only, reps, pad;
    size_t a_tile, b_tile, a_rep0, a_rep1, a_rep2, b_rep;
    __device__ __forceinline__ void init(int nM_, int nN_, int latent_only_, int reps_, int lda, int ldb, size_t ar1 = 0, size_t ar2 = 0, size_t brep = 0) {
        nM = nM_; nN = nN_; nwg = nM * nN; G = (int)gridDim.x; c = opaque_bid(); latent_only = latent_only_; reps = reps_; pad = 0;
        a_tile = (size_t)BM * lda * 2; b_tile = (size_t)BM * ldb * 2; a_rep0 = 0; a_rep1 = ar1; a_rep2 = ar2 - ar1; b_rep = brep;
    }
    __device__ __forceinline__ bool next(int i, Unit& u) const {
        int it = i, br = 0;
        if (reps == 3) { it = i / 3; br = i - it * 3; }
        const long L = (long)it * G + c; if (L >= nwg) return false;
        int wgid = (int)L; { const int q = nwg / NXCD, r = nwg % NXCD, xcd = wgid % NXCD, off = wgid / NXCD; wgid = (xcd < r ? xcd * (q + 1) : r * (q + 1) + (xcd - r) * q) + off; }
        const int nig = WGM * nN, gid = wgid / nig, fm = gid * WGM, gsz = (nM - fm) < WGM ? (nM - fm) : WGM;
        const int pmv = fm + ((wgid % nig) % gsz); u.pn = (wgid % nig) / gsz;
        u.pm = latent_only ? (pmv >> 3) * 9 + (pmv & 7) : pmv; u.br = br; u.pad = 0;
        u.aoff = (size_t)u.pm * a_tile + (size_t)(br > 0 ? 1 : 0) * (a_rep1 + (size_t)(br - 1) * a_rep2);
        u.boff = (size_t)u.pn * b_tile + (size_t)br * b_rep;
        return true;
    }
};


struct EpiPlain {
    bf16_t* O; int ldc;
    __device__ __forceinline__ void operator()(const f32x4 (&acc)[2][2][4][2], const Unit& u, int wr, int wc, int fr, int fq) const {
        const int row0 = u.pm * BM + wr * 64 + fr, col0 = u.pn * BM + wc * 32 + 8 * fq;
#pragma unroll
        for (int ai = 0; ai < 2; ++ai)
#pragma unroll
            for (int m = 0; m < 4; ++m) { bf16_t* rowp = O + (size_t)(row0 + ai * HALF + m * 16) * ldc + col0;
#pragma unroll
                for (int bj = 0; bj < 2; ++bj) { const f32x4 v0 = acc[ai][bj][m][0], v1 = acc[ai][bj][m][1];
                    u32x4 w; w.x = pk_bf16(v0[0], v0[1]); w.y = pk_bf16(v0[2], v0[3]); w.z = pk_bf16(v1[0], v1[1]); w.w = pk_bf16(v1[2], v1[3]);
                    *(u32x4*)(rowp + bj * HALF) = w; } }
    }
};
struct EpiSwiglu {
    bf16_t* O;
    __device__ __forceinline__ void operator()(const f32x4 (&acc)[2][2][4][2], const Unit& u, int wr, int wc, int fr, int fq) const {
        const int row0 = u.pm * BM + wr * 64 + fr, col0 = (u.pn * BM + wc * 32 + 8 * fq) >> 1;
#pragma unroll
        for (int ai = 0; ai < 2; ++ai)
#pragma unroll
            for (int m = 0; m < 4; ++m) { bf16_t* rowp = O + (size_t)(row0 + ai * HALF + m * 16) * DFF + col0;
#pragma unroll
                for (int bj = 0; bj < 2; ++bj) { const f32x4 a = acc[ai][bj][m][0], g = acc[ai][bj][m][1];
                    u32x2 w; w.x = pk_bf16(fast_silu(a[0]) * g[0], fast_silu(a[1]) * g[1]); w.y = pk_bf16(fast_silu(a[2]) * g[2], fast_silu(a[3]) * g[3]);
                    *(u32x2*)(rowp + bj * (HALF / 2)) = w; } }
    }
};
struct EpiQkvGate {
    bf16_t* P; unsigned char* G8; const float* bgate;
    __device__ __forceinline__ void operator()(const f32x4 (&acc)[2][2][4][2], const Unit& u, int wr, int wc, int fr, int fq) const {
        const int row0 = u.pm * BM + wr * 64 + fr;
        if (u.pn < 15) {
            const int col0 = u.pn * BM + wc * 32 + 8 * fq;
#pragma unroll
            for (int ai = 0; ai < 2; ++ai)
#pragma unroll
                for (int m = 0; m < 4; ++m) { bf16_t* rowp = P + (size_t)(row0 + ai * HALF + m * 16) * QKVC + col0;
#pragma unroll
                    for (int bj = 0; bj < 2; ++bj) { const f32x4 v0 = acc[ai][bj][m][0], v1 = acc[ai][bj][m][1];
                        u32x4 w; w.x = pk_bf16(v0[0], v0[1]); w.y = pk_bf16(v0[2], v0[3]); w.z = pk_bf16(v1[0], v1[1]); w.w = pk_bf16(v1[2], v1[3]);
                        *(u32x4*)(rowp + bj * HALF) = w; } }
        } else {
            const int col0 = (u.pn - 15) * BM + wc * 32 + 8 * fq;
            f32x4 bv[2][2];
#pragma unroll
            for (int bj = 0; bj < 2; ++bj)
#pragma unroll
                for (int n = 0; n < 2; ++n) bv[bj][n] = *(const f32x4*)(bgate + col0 + bj * HALF + 4 * n);
#pragma unroll
            for (int ai = 0; ai < 2; ++ai)
#pragma unroll
                for (int m = 0; m < 4; ++m) { unsigned char* rowp = G8 + (size_t)(row0 + ai * HALF + m * 16) * GATEC + col0;
#pragma unroll
                    for (int bj = 0; bj < 2; ++bj) { const f32x4 v0 = acc[ai][bj][m][0] + bv[bj][0], v1 = acc[ai][bj][m][1] + bv[bj][1];
                        unsigned q[8];
#pragma unroll
                        for (int j = 0; j < 4; ++j) { q[j] = (unsigned)__float2uint_rn(fast_sigmoid(v0[j]) * 255.0f); q[4 + j] = (unsigned)__float2uint_rn(fast_sigmoid(v1[j]) * 255.0f); }
                        u32x2 w; w.x = q[0] | (q[1] << 8) | (q[2] << 16) | (q[3] << 24); w.y = q[4] | (q[5] << 8) | (q[6] << 16) | (q[7] << 24);
                        *(u32x2*)(rowp + bj * HALF) = w; } }
        }
    }
};
struct EpiMerge {
    bf16_t* O; const unsigned char* G8;
    __device__ __forceinline__ void operator()(const f32x4 (&acc)[2][2][4][2], const Unit& u, int wr, int wc, int fr, int fq) const {
        const int row0 = u.pm * BM + wr * 64 + fr, col0 = u.pn * BM + wc * 32 + 8 * fq;
        const float s = 1.0f / 255.0f;
#pragma unroll
        for (int ai = 0; ai < 2; ++ai) {
            u32x2 gq[4][2]; u32x4 old[4][2];
#pragma unroll
            for (int m = 0; m < 4; ++m) { const size_t r = (size_t)(row0 + ai * HALF + m * 16);
#pragma unroll
                for (int bj = 0; bj < 2; ++bj) gq[m][bj] = *(const u32x2*)(G8 + r * GATEC + u.br * DM + col0 + bj * HALF); }
            if (u.br > 0) {
#pragma unroll
                for (int m = 0; m < 4; ++m) { const size_t r = (size_t)(row0 + ai * HALF + m * 16);
#pragma unroll
                    for (int bj = 0; bj < 2; ++bj) old[m][bj] = *(const u32x4*)(O + r * DM + col0 + bj * HALF); }
            } else {
#pragma unroll
                for (int m = 0; m < 4; ++m)
#pragma unroll
                    for (int bj = 0; bj < 2; ++bj) old[m][bj] = (u32x4){0u, 0u, 0u, 0u};
            }
#pragma unroll
            for (int m = 0; m < 4; ++m) { const size_t r = (size_t)(row0 + ai * HALF + m * 16);
#pragma unroll
                for (int bj = 0; bj < 2; ++bj) { const f32x4 v0 = acc[ai][bj][m][0], v1 = acc[ai][bj][m][1]; const u32x2 g = gq[m][bj]; const u32x4 od = old[m][bj];
                    float o[8];
                    o[0] = v0[0] * (s * (float)(g.x & 255u)) + bf_lo(od.x); o[1] = v0[1] * (s * (float)((g.x >> 8) & 255u)) + bf_hi(od.x);
                    o[2] = v0[2] * (s * (float)((g.x >> 16) & 255u)) + bf_lo(od.y); o[3] = v0[3] * (s * (float)(g.x >> 24)) + bf_hi(od.y);
                    o[4] = v1[0] * (s * (float)(g.y & 255u)) + bf_lo(od.z); o[5] = v1[1] * (s * (float)((g.y >> 8) & 255u)) + bf_hi(od.z);
                    o[6] = v1[2] * (s * (float)((g.y >> 16) & 255u)) + bf_lo(od.w); o[7] = v1[3] * (s * (float)(g.y >> 24)) + bf_hi(od.w);
                    u32x4 w; w.x = pk_bf16(o[0], o[1]); w.y = pk_bf16(o[2], o[3]); w.z = pk_bf16(o[4], o[5]); w.w = pk_bf16(o[6], o[7]);
                    *(u32x4*)(O + r * DM + col0 + bj * HALF) = w; } }
        }
    }
};

template <class Epi>
__device__ __forceinline__ void gemm_phase(LAS unsigned char* lds, const Gemm g, const Order& S, const Epi& E) {
    const int tid = opaque_tid(), wid = __builtin_amdgcn_readfirstlane(tid >> 6), lane = tid & 63, wr = wid >> 2, wc = wid & 3, fr = lane & 15, fq = lane >> 4;
    const int K = g.K, nt = K / BK;
    unsigned voffA[2], voffB[2];
#pragma unroll
    for (int i = 0; i < 2; ++i) { int R, C; stage_rc(tid * 16 + i * 8192, R, C); const int Rb = (R & ~31) + perm32(R & 31);
        voffA[i] = (unsigned)(R * g.lda + C) * 2u; voffB[i] = (unsigned)(Rb * g.ldb + C) * 2u; }
    const size_t kstep = (size_t)(BK * 2);
    const size_t hstepA = (size_t)HALF * g.lda * 2, hstepB = (size_t)HALF * g.ldb * 2;
    const unsigned ldsw = (unsigned)wid * 1024u;
    const int aoff = lds_byte(wr * 64 + fr, fq * 8), boff = lds_byte(wc * 32 + fr, fq * 8);
#define PG8_SA(b, h) (((b) * 2 + (h)) * HTB)
#define PG8_SB(b, h) ((4 + (b) * 2 + (h)) * HTB)
#define PG8_STAGE(bufoff, gbase, voff) do { _Pragma("unroll") for (int _i = 0; _i < 2; ++_i) \
        __builtin_amdgcn_global_load_lds((const unsigned*)((const char*)(gbase) + (voff)[_i]), (LAS unsigned*)(lds + (bufoff) + ldsw + _i * 8192), 16, 0, 0); } while (0)
#define PG8_LDA(dst, b, h) do { _Pragma("unroll") for (int m = 0; m < 4; ++m) _Pragma("unroll") for (int k = 0; k < 2; ++k) dst[m][k] = *(const LAS bf16x8*)(lds + PG8_SA(b, h) + aoff + m * 2048 + k * 1024); } while (0)
#define PG8_LDB(dst, b, h) do { _Pragma("unroll") for (int n = 0; n < 2; ++n) _Pragma("unroll") for (int k = 0; k < 2; ++k) dst[n][k] = *(const LAS bf16x8*)(lds + PG8_SB(b, h) + boff + n * 2048 + k * 1024); } while (0)
#define PG8_MMA(ai, bj, At, Bt) do { __builtin_amdgcn_s_setprio(1); _Pragma("unroll") for (int m = 0; m < 4; ++m) _Pragma("unroll") for (int n = 0; n < 2; ++n) _Pragma("unroll") for (int k = 0; k < 2; ++k) \
        acc[ai][bj][m][n] = __builtin_amdgcn_mfma_f32_16x16x32_bf16(Bt[n][k], At[m][k], acc[ai][bj][m][n], 0, 0, 0); __builtin_amdgcn_s_setprio(0); } while (0)
#define PG8_WAIT_V(n) asm volatile("s_waitcnt vmcnt(" #n ")" ::: "memory")
#define PG8_WAIT_L(n) asm volatile("s_waitcnt lgkmcnt(" #n ")" ::: "memory")
#define PG8_BAR __builtin_amdgcn_s_barrier()
#define PG8_SCHED __builtin_amdgcn_sched_barrier(0)
    Unit cur, nxt; int ui = 0;
    if (!S.next(0, cur)) return;
    f32x4 acc[2][2][4][2];
#pragma unroll
    for (int a = 0; a < 2; ++a)
#pragma unroll
        for (int b = 0; b < 2; ++b)
#pragma unroll
            for (int m = 0; m < 4; ++m)
#pragma unroll
                for (int n = 0; n < 2; ++n) acc[a][b][m][n] = (f32x4){0.f, 0.f, 0.f, 0.f};
    bf16x8 At[4][2], B0[2][2], B1[2][2];
    const char* cA = (const char*)g.A + cur.aoff; const char* cB = (const char*)g.Bt + cur.boff;
    PG8_STAGE(PG8_SB(0, 0), cB, voffB); PG8_STAGE(PG8_SA(0, 0), cA, voffA); PG8_STAGE(PG8_SB(0, 1), cB + hstepB, voffB); PG8_STAGE(PG8_SA(0, 1), cA + hstepA, voffA);
    if (wr == 1) PG8_BAR;
    PG8_WAIT_V(4); PG8_BAR;
    PG8_STAGE(PG8_SB(1, 0), cB + kstep, voffB); PG8_STAGE(PG8_SA(1, 0), cA + kstep, voffA); PG8_STAGE(PG8_SB(1, 1), cB + hstepB + kstep, voffB);
    PG8_WAIT_V(6); PG8_BAR;
    for (;;) {
        const bool has_next = S.next(ui + 1, nxt);
        const char* nA = has_next ? (const char*)g.A + nxt.aoff : cA; const char* nB = has_next ? (const char*)g.Bt + nxt.boff : cB;
        for (int t = 0; t < nt; t += 2) {
            const bool last = (t == nt - 2);
            const char* a1 = cA + (size_t)(t + 1) * kstep;
            const char* a2 = last ? nA : cA + (size_t)(t + 2) * kstep; const char* b2 = last ? nB : cB + (size_t)(t + 2) * kstep;
            const char* a3 = a2 + kstep; const char* b3 = b2 + kstep;
            PG8_LDB(B0, 0, 0); PG8_SCHED; PG8_LDA(At, 0, 0); PG8_STAGE(PG8_SA(1, 1), a1 + hstepA, voffA);
            PG8_WAIT_L(8); PG8_BAR; PG8_WAIT_L(0); PG8_MMA(0, 0, At, B0); PG8_BAR; PG8_SCHED;
            PG8_LDB(B1, 0, 1); PG8_STAGE(PG8_SB(0, 0), b2, voffB);
            PG8_BAR; PG8_WAIT_L(0); PG8_MMA(0, 1, At, B1); PG8_BAR;
            PG8_LDA(At, 0, 1); PG8_STAGE(PG8_SA(0, 0), a2, voffA);
            PG8_BAR; PG8_WAIT_L(0); PG8_MMA(1, 0, At, B0); PG8_BAR; PG8_SCHED;
            PG8_STAGE(PG8_SB(0, 1), b2 + hstepB, voffB);
            PG8_WAIT_V(6); PG8_BAR; PG8_MMA(1, 1, At, B1); PG8_BAR;
            PG8_LDB(B0, 1, 0); PG8_SCHED; PG8_LDA(At, 1, 0); PG8_STAGE(PG8_SA(0, 1), a2 + hstepA, voffA);
            PG8_WAIT_L(8); PG8_BAR; PG8_WAIT_L(0); PG8_MMA(0, 0, At, B0); PG8_BAR; PG8_SCHED;
            PG8_LDB(B1, 1, 1); PG8_STAGE(PG8_SB(1, 0), b3, voffB);
            PG8_BAR; PG8_WAIT_L(0); PG8_MMA(0, 1, At, B1); PG8_BAR;
            PG8_LDA(At, 1, 1); PG8_STAGE(PG8_SA(1, 0), a3, voffA);
            PG8_BAR; PG8_WAIT_L(0); PG8_MMA(1, 0, At, B0); PG8_BAR; PG8_SCHED;
            PG8_STAGE(PG8_SB(1, 1), b3 + hstepB, voffB);
            PG8_WAIT_V(6); PG8_BAR; PG8_MMA(1, 1, At, B1); PG8_BAR;
        }
        E(acc, cur, wr, wc, fr, fq);
        if (!has_next) break;
#pragma unroll
        for (int a = 0; a < 2; ++a)
#pragma unroll
            for (int b = 0; b < 2; ++b)
#pragma unroll
                for (int m = 0; m < 4; ++m)
#pragma unroll
                    for (int n = 0; n < 2; ++n) acc[a][b][m][n] = (f32x4){0.f, 0.f, 0.f, 0.f};
        cur = nxt; cA = nA; cB = nB; ++ui;
    }
    PG8_WAIT_V(0);
    if (wr == 0) PG8_BAR;
    PG8_BAR;
#undef PG8_SA
#undef PG8_SB
#undef PG8_STAGE
#undef PG8_LDA
#undef PG8_LDB
#undef PG8_MMA
#undef PG8_WAIT_V
#undef PG8_WAIT_L
#undef PG8_BAR
#undef PG8_SCHED
}
}

__device__ __forceinline__ void conv_tile(float* lf, const float* __restrict__ src, int ld, bf16_t* dst, int K, int tv, int tk, int map) {
    const int tid = opaque_tid();
    { const int vl = tid & 63, ks = tid >> 6; const int v = tv * 64 + vl;
      const int sc = map ? (((v & 7) < 4) ? ((v >> 3) * 4 + (v & 7)) : (DFF + (v >> 3) * 4 + (v & 7) - 4)) : v;
#pragma unroll
      for (int kk = 0; kk < 8; ++kk) { const int kl = kk * 8 + ks; lf[kl * 65 + vl] = src[(size_t)(tk * 64 + kl) * ld + sc]; } }
    __syncthreads();
    { const int vl = tid >> 3, ch = tid & 7; float f[8];
#pragma unroll
      for (int e = 0; e < 8; ++e) f[e] = lf[(ch * 8 + e) * 65 + vl];
      u32x4 w; w.x = pk_bf16(f[0], f[1]); w.y = pk_bf16(f[2], f[3]); w.z = pk_bf16(f[4], f[5]); w.w = pk_bf16(f[6], f[7]);
      *(u32x4*)(dst + (size_t)(tv * 64 + vl) * K + tk * 64 + ch * 8) = w; }
    __syncthreads();
}
constexpr int CONV_FFN_TILES = 1408 + 704, CONV_MIX_TILES = 1728 + 384 + 256;
__device__ __forceinline__ void conv_ffn(const Params& p, float* lf, int l, int which, int it) {
    if (it < 1408) conv_tile(lf, p.w_ffn_in + (size_t)(l * 2 + which) * DM * 2 * DFF, 2 * DFF, (bf16_t*)(p.ws + WS_WFI), DM, it >> 4, it & 15, 1);
    else { it -= 1408; conv_tile(lf, p.w_ffn_out + (size_t)(l * 2 + which) * DFF * DM, DM, (bf16_t*)(p.ws + WS_WFO), DFF, it / 44, it % 44, 0); }
}
__device__ __forceinline__ void conv_mix(const Params& p, float* lf, int l, int it) {
    if (it < 1728) conv_tile(lf, p.w_in + (size_t)l * DM * INC, INC, (bf16_t*)(p.ws + WS_WMI), DM, it >> 4, it & 15, 0);
    else if (it < 1728 + 384) { const int j = it - 1728, br = j >> 7, jj = j & 127;
        conv_tile(lf, p.w_branch + (size_t)(l * 3 + br) * 512 * DM, DM, (bf16_t*)(p.ws + WS_WMB) + (size_t)br * DM * 512, 512, jj >> 3, jj & 7, 0); }
    else { const int j = it - 2112; conv_tile(lf, p.w_out + (size_t)l * DM * DM, DM, (bf16_t*)(p.ws + WS_WMO), DM, j >> 4, j & 15, 0); }
}

__device__ __forceinline__ void mod_item(const Params& p, float* lf, int it) {
    float* sl = lf;
    float* red = lf + 1024 * 20;
    const int tid = opaque_tid(), lane = tid & 63, w = tid >> 6;
    const int l = it / 144, col0 = (it % 144) * 64;
    for (int idx = tid; idx < 17 * 1024; idx += NTHREADS) { const int r = idx >> 10, k = idx & 1023; const float v = r < 16 ? p.c[r * 1024 + k] : p.c_ctx[k]; sl[k * 20 + r] = v / (1.0f + __expf(-v)); }
    __syncthreads();
    float acc[17];
#pragma unroll
    for (int r = 0; r < 17; ++r) acc[r] = 0.f;
    const float* wp = p.w_mod + ((size_t)l * DM + w * 128) * MODC + col0 + lane;
#pragma unroll 4
    for (int k = 0; k < 128; ++k) {
        const float wv = wp[(size_t)k * MODC];
        const float* sp = sl + (w * 128 + k) * 20;
        const f32x4 s0 = *(const f32x4*)(sp), s1 = *(const f32x4*)(sp + 4), s2 = *(const f32x4*)(sp + 8), s3 = *(const f32x4*)(sp + 12); const float s4 = sp[16];
        acc[0] += s0[0] * wv; acc[1] += s0[1] * wv; acc[2] += s0[2] * wv; acc[3] += s0[3] * wv;
        acc[4] += s1[0] * wv; acc[5] += s1[1] * wv; acc[6] += s1[2] * wv; acc[7] += s1[3] * wv;
        acc[8] += s2[0] * wv; acc[9] += s2[1] * wv; acc[10] += s2[2] * wv; acc[11] += s2[3] * wv;
        acc[12] += s3[0] * wv; acc[13] += s3[1] * wv; acc[14] += s3[2] * wv; acc[15] += s3[3] * wv; acc[16] += s4 * wv;
    }
#pragma unroll
    for (int r = 0; r < 17; ++r) red[(w * 17 + r) * 64 + lane] = acc[r];
    __syncthreads();
    float* mod = (float*)(p.ws + WS_MOD);
    for (int o = tid; o < 17 * 64; o += NTHREADS) { const int r = o >> 6, ln = o & 63; float s = p.b_mod[l * MODC + col0 + ln];
#pragma unroll
        for (int ww = 0; ww < 8; ++ww) s += red[(ww * 17 + r) * 64 + ln];
        mod[((size_t)l * 17 + r) * MODC + col0 + ln] = s; }
    __syncthreads();
}
__device__ __forceinline__ void misc_item(const Params& p) {
    const int tid = opaque_tid();
    f32x2* rope = (f32x2*)(p.ws + WS_ROPE);
    for (int e = tid; e < 1024; e += NTHREADS) { const int pos = e >> 4, f = e & 15;
        const float inv = powf(10000.0f, -(float)f / 16.0f); const float ang = (float)pos * inv;
        double a = (double)ang * 0.15915494309189535; a -= floor(a); const float fr = (float)a;
        rope[e] = (f32x2){__builtin_amdgcn_cosf(fr), __builtin_amdgcn_sinf(fr)}; }
    float* misc = (float*)(p.ws + WS_MISC);
    if (tid < DEPTH) { const int l = tid; const float* dl = p.diff_lambda + l * 256; float s1 = 0.f, s2 = 0.f;
        for (int i = 0; i < 64; ++i) { s1 += dl[i] * dl[64 + i]; s2 += dl[128 + i] * dl[192 + i]; }
        const float lam_init = 0.8f - 0.6f * expf(-0.3f * (float)l);
        misc[l * 16 + 0] = expf(s1) - expf(s2) + lam_init; misc[l * 16 + 1] = lam_init; }
    if (tid >= 64 && tid < 64 + DEPTH * 8) { const int j = tid - 64, l = j >> 3, dh = j & 7;
        const float x = p.ret_logit[l * 8 + dh]; misc[l * 16 + 4 + dh] = -log1pf(expf(-x)) * 1.4426950408889634f; }
}

__device__ __forceinline__ void ephase_rows(const Params& p, bool first, int lp, int sp, float gs, const bf16_t* ysrc, int ln, int sn, bool latent_only, int dummy) {
    const int tid = opaque_tid(); const int lane = tid & 63, w = tid >> 6;
    const float* mod = (const float*)(p.ws + WS_MOD);
    float* hc = (float*)(p.ws + WS_HC);
    bf16_t* Y = (bf16_t*)(p.ws + WS_Y);
    for (int t = blockIdx.x * 8 + w; t < NT; t += gridDim.x * 8) {
        const int b = t / TPB, n = t - b * TPB; const bool isctx = n >= SEQ;
        if (latent_only && isctx) continue;
        float* hp = isctx ? hc + (size_t)(b * CTXL + n - SEQ) * DM : p.out + (size_t)(b * SEQ + n) * DM;
        const float* hsrc = first ? (isctx ? p.ctx + (size_t)(b * CTXL + n - SEQ) * DM : p.x + (size_t)(b * SEQ + n) * DM) : hp;
        const int mrow = isctx ? 16 : b;
        f32x4 h[4];
#pragma unroll
        for (int i = 0; i < 4; ++i) h[i] = *(const f32x4*)(hsrc + i * 256 + lane * 4);
        if (!first) {
            const float* mp = mod + ((size_t)lp * 17 + mrow) * MODC + sp * 3072 + 2048;
            const float* gpost = p.norm_g + (size_t)(lp * 6 + 2 * sp + 1) * DM;
            f32x4 y[4]; float ss = 0.f;
#pragma unroll
            for (int i = 0; i < 4; ++i) { const u32x2 v = *(const u32x2*)(ysrc + (size_t)t * DM + i * 256 + lane * 4);
                y[i] = (f32x4){bf_lo(v.x), bf_hi(v.x), bf_lo(v.y), bf_hi(v.y)}; ss += y[i][0] * y[i][0] + y[i][1] * y[i][1] + y[i][2] * y[i][2] + y[i][3] * y[i][3]; }
            ss = wave_sum(ss); const float r = rsqrtf(ss * (1.0f / DM) + EPS);
#pragma unroll
            for (int i = 0; i < 4; ++i) { const f32x4 ga = *(const f32x4*)(mp + i * 256 + lane * 4), gp = *(const f32x4*)(gpost + i * 256 + lane * 4);
                h[i] += gs * ga * (y[i] * r * gp); }
        }
#pragma unroll
        for (int i = 0; i < 4; ++i) if (!dummy) *(f32x4*)(hp + i * 256 + lane * 4) = h[i];
        if (sn >= 0) {
            float ss = 0.f;
#pragma unroll
            for (int i = 0; i < 4; ++i) ss += h[i][0] * h[i][0] + h[i][1] * h[i][1] + h[i][2] * h[i][2] + h[i][3] * h[i][3];
            ss = wave_sum(ss); const float r = rsqrtf(ss * (1.0f / DM) + EPS);
            const float* mp = mod + ((size_t)ln * 17 + mrow) * MODC + sn * 3072;
            const float* gpre = p.norm_g + (size_t)(ln * 6 + 2 * sn) * DM;
#pragma unroll
            for (int i = 0; i < 4; ++i) { const f32x4 sh = *(const f32x4*)(mp + i * 256 + lane * 4), sc = *(const f32x4*)(mp + 1024 + i * 256 + lane * 4), gp = *(const f32x4*)(gpre + i * 256 + lane * 4);
                const f32x4 o = h[i] * r * gp * (1.0f + sc) + sh;
                u32x2 wv; wv.x = pk_bf16(o[0], o[1]); wv.y = pk_bf16(o[2], o[3]);
                if (!dummy) *(u32x2*)(Y + (size_t)t * DM + i * 256 + lane * 4) = wv; }
        }
    }
}

__device__ __forceinline__ void rope_phase(const Params& p, int l, int dummy) {
    bf16_t* P = (bf16_t*)(p.ws + WS_P);
    const f32x2* rope = (const f32x2*)(p.ws + WS_ROPE);
    const long total = (long)NT * 136;
    const int tid = opaque_tid();
    for (long idx = (long)blockIdx.x * NTHREADS + tid; idx < total; idx += (long)gridDim.x * NTHREADS) {
        const int t = (int)(idx / 136), rem = (int)(idx - (long)t * 136), gi = rem >> 2, j = rem & 3;
        const int n = t % TPB; const bool isctx = n >= SEQ;
        int col;
        if (gi < 8) col = gi * 64; else if (gi < 16) col = 512 + (gi - 8) * 64; else if (gi < 20) col = 1536 + (gi - 16) * 64; else if (gi < 24) col = 1792 + (gi - 20) * 64;
        else if (gi < 32) col = 3072 + (gi - 24) * 64; else col = 3584 + (gi - 32) * 64;
        bf16_t* bp = P + (size_t)t * QKVC + col + j * 8;
        const u32x4 r1 = *(const u32x4*)bp, r2 = *(const u32x4*)(bp + 32);
        float x1[8] = {bf_lo(r1.x), bf_hi(r1.x), bf_lo(r1.y), bf_hi(r1.y), bf_lo(r1.z), bf_hi(r1.z), bf_lo(r1.w), bf_hi(r1.w)};
        float x2[8] = {bf_lo(r2.x), bf_hi(r2.x), bf_lo(r2.y), bf_hi(r2.y), bf_lo(r2.z), bf_hi(r2.z), bf_lo(r2.w), bf_hi(r2.w)};
        if (gi >= 24) {
            float ss = 0.f;
#pragma unroll
            for (int e = 0; e < 8; ++e) ss += x1[e] * x1[e] + x2[e] * x2[e];
            ss += __shfl_xor(ss, 1); ss += __shfl_xor(ss, 2);
            const float r = rsqrtf(ss * (1.0f / 64.0f) + EPS);
            const float* g = p.qk_norm_g + (size_t)(l * 2 + (gi >= 32 ? 1 : 0)) * 64 + j * 8;
#pragma unroll
            for (int e = 0; e < 8; ++e) { x1[e] *= r * g[e]; x2[e] *= r * g[32 + e]; }
        }
        if (!isctx) {
            const int pos = (j < 2) ? (n >> 6) : (n & 63);
            const f32x2* cs = rope + pos * 16 + (j & 1) * 8;
#pragma unroll
            for (int e = 0; e < 8; ++e) { const f32x2 v = cs[e]; const float a = x1[e], bq = x2[e]; x1[e] = a * v.x - bq * v.y; x2[e] = a * v.y + bq * v.x; }
        }
        if ((gi >= 24 || !isctx) && !dummy) {
            u32x4 w1, w2;
            w1.x = pk_bf16(x1[0], x1[1]); w1.y = pk_bf16(x1[2], x1[3]); w1.z = pk_bf16(x1[4], x1[5]); w1.w = pk_bf16(x1[6], x1[7]);
            w2.x = pk_bf16(x2[0], x2[1]); w2.y = pk_bf16(x2[2], x2[3]); w2.z = pk_bf16(x2[4], x2[5]); w2.w = pk_bf16(x2[6], x2[7]);
            *(u32x4*)bp = w1; *(u32x4*)(bp + 32) = w2;
        }
    }
}

template <int KIND>
__device__ __forceinline__ void attn_item(unsigned char* lds, bf16_t* P, const Params& p, int l, int b, int head, int qb, int isctx, int dummy) {
    constexpr int KW = (KIND == 0) ? 128 : 64, DV = (KIND == 2) ? 64 : 128, NDB = DV / 16;
    constexpr int KSTR = KW * 2 + 16, VSTR = DV * 2 + 32, KBYTES = 64 * KSTR, VBYTES = 64 * VSTR;
    constexpr int KCH = KW / 64, VCH = DV / 64;
    const int tid = opaque_tid(), lane = tid & 63, w = tid >> 6, lq = lane & 15, g = lane >> 4;
    const float* misc = (const float*)(p.ws + WS_MISC) + l * 16;
    const int comp = (KIND == 0) ? (w >> 2) : 0;
    const int qn0 = (KIND == 0) ? qb * 128 + (w & 3) * 32 : qb * 256 + w * 32;
    const size_t rowbase = (size_t)b * TPB + (isctx ? SEQ : 0);
    const int qcol = (KIND == 0) ? head * 128 + comp * 64 : (KIND == 1) ? 1536 + head * 64 : 3072 + head * 64;
    const int kcol = (KIND == 0) ? 512 + head * 128 : (KIND == 1) ? 1792 + head * 64 : 3584 + (head >> 2) * 64;
    const int vcol = (KIND == 0) ? 1024 + head * 128 : (KIND == 1) ? 2048 + head * 128 : 3712 + (head >> 2) * 64;
    const int kt0 = isctx ? 32 : 0, nkt = isctx ? 4 : 36;
    const size_t keyrow0 = (size_t)b * TPB + (size_t)kt0 * 64;

    bf16x8 qf[2][2];
#pragma unroll
    for (int qs = 0; qs < 2; ++qs)
#pragma unroll
        for (int ks = 0; ks < 2; ++ks) qf[qs][ks] = *(const bf16x8*)(P + (rowbase + qn0 + qs * 16 + lq) * QKVC + qcol + ks * 32 + g * 8);

    float lf2 = 0.f, lb2 = 0.f;
    if (KIND == 1) { lf2 = misc[4 + head]; lb2 = misc[8 + head]; }

    f32x4 O[NDB][2];
#pragma unroll
    for (int db = 0; db < NDB; ++db) { O[db][0] = (f32x4){0.f, 0.f, 0.f, 0.f}; O[db][1] = (f32x4){0.f, 0.f, 0.f, 0.f}; }
    float mrun[2] = {-1e30f, -1e30f}, lrun[2] = {0.f, 0.f};

    u32x4 kreg[KCH], vreg[VCH];
    int krow[KCH], kcc[KCH], vrow[VCH], vcc[VCH];
#pragma unroll
    for (int i = 0; i < KCH; ++i) { const int id = tid + i * NTHREADS; krow[i] = id / (KW / 8); kcc[i] = id % (KW / 8); }
#pragma unroll
    for (int i = 0; i < VCH; ++i) { const int id = tid + i * NTHREADS; vrow[i] = id / (DV / 8); vcc[i] = id % (DV / 8); }
#define ATT_LOAD(t) do { const size_t r0 = keyrow0 + (size_t)(t) * 64; \
        _Pragma("unroll") for (int i = 0; i < KCH; ++i) kreg[i] = *(const u32x4*)(P + (r0 + krow[i]) * QKVC + kcol + kcc[i] * 8); \
        _Pragma("unroll") for (int i = 0; i < VCH; ++i) vreg[i] = *(const u32x4*)(P + (r0 + vrow[i]) * QKVC + vcol + vcc[i] * 8); } while (0)
#define ATT_STORE(buf) do { unsigned char* kb_ = lds + (buf) * KBYTES; unsigned char* vb_ = lds + 2 * KBYTES + (buf) * VBYTES; \
        _Pragma("unroll") for (int i = 0; i < KCH; ++i) *(u32x4*)(kb_ + krow[i] * KSTR + kcc[i] * 16) = kreg[i]; \
        _Pragma("unroll") for (int i = 0; i < VCH; ++i) *(u32x4*)(vb_ + vrow[i] * VSTR + vcc[i] * 16) = vreg[i]; } while (0)

    ATT_LOAD(0); ATT_STORE(0);
    __syncthreads();
    const unsigned lds_base = (unsigned)(uintptr_t)(LAS unsigned char*)lds;
    const float csc = 0.125f * 1.4426950408889634f;
    float dfa0 = 0.f, dba0 = 0.f, f16 = 0.f, b16 = 0.f, dfr[4] = {1.f, 1.f, 1.f, 1.f}, dbr[4] = {1.f, 1.f, 1.f, 1.f};
    if (KIND == 1) {
        dfa0 = __builtin_amdgcn_exp2f(-lf2 * (float)(4 * g)) * 0.125f; dba0 = __builtin_amdgcn_exp2f(lb2 * (float)(4 * g)) * 0.125f;
        f16 = __builtin_amdgcn_exp2f(-lf2 * 16.0f); b16 = __builtin_amdgcn_exp2f(lb2 * 16.0f);
#pragma unroll
        for (int i = 1; i < 4; ++i) { dfr[i] = __builtin_amdgcn_exp2f(-lf2 * (float)i); dbr[i] = __builtin_amdgcn_exp2f(lb2 * (float)i); }
    }
#define ATT_TR(dst, db) asm volatile("ds_read_b64_tr_b16 %0, %4 offset:%5\n\tds_read_b64_tr_b16 %1, %4 offset:%6\n\tds_read_b64_tr_b16 %2, %4 offset:%7\n\tds_read_b64_tr_b16 %3, %4 offset:%8" \
                         : "=&v"(dst[0]), "=&v"(dst[1]), "=&v"(dst[2]), "=&v"(dst[3]) \
                         : "v"(vaddr), "i"((db) * 32), "i"((db) * 32 + 16 * VSTR), "i"((db) * 32 + 32 * VSTR), "i"((db) * 32 + 48 * VSTR) : "memory")
    for (int t = 0; t < nkt; ++t) {
        const int buf = t & 1;
        if (t + 1 < nkt) ATT_LOAD(t + 1);
        const unsigned char* Kb = lds + buf * KBYTES;
        const unsigned vaddr = lds_base + 2 * KBYTES + buf * VBYTES + (4 * g + (lq >> 2)) * VSTR + (lq & 3) * 8;
        f32x4 s[4][2];
#pragma unroll
        for (int kb = 0; kb < 4; ++kb) {
            const bf16x8 kf0 = *(const bf16x8*)(Kb + (kb * 16 + lq) * KSTR + comp * 128 + g * 16);
            const bf16x8 kf1 = *(const bf16x8*)(Kb + (kb * 16 + lq) * KSTR + comp * 128 + 64 + g * 16);
#pragma unroll
            for (int qs = 0; qs < 2; ++qs) {
                f32x4 a = (f32x4){0.f, 0.f, 0.f, 0.f};
                a = __builtin_amdgcn_mfma_f32_16x16x32_bf16(kf0, qf[qs][0], a, 0, 0, 0);
                a = __builtin_amdgcn_mfma_f32_16x16x32_bf16(kf1, qf[qs][1], a, 0, 0, 0);
                s[kb][qs] = a;
            }
        }
        s16x4 vr[2][4];
        ATT_TR(vr[0], 0);
        if (KIND == 1) {
            const int kk0 = (kt0 + t) * 64;
            const int PF0 = kk0 < SEQ ? kk0 + CTXL : kk0 - SEQ;
            const int pfq_min = isctx ? qn0 : qn0 + CTXL, pbq_min = isctx ? SEQ + qn0 : qn0;
            const bool f_full = (pfq_min - PF0 - 63 >= 0), f_none = (pfq_min + 31 - PF0 < 0);
            const bool b_full = (kk0 - (pbq_min + 31) >= 0), b_none = (kk0 + 63 - pbq_min < 0);
            const bool clean = (f_full || f_none) && (b_full || b_none);
#pragma unroll
            for (int qs = 0; qs < 2; ++qs) {
                const int qpf = pfq_min + qs * 16 + lq, qpb = pbq_min + qs * 16 + lq;
                const int tf = qpf - PF0 - 4 * g, tb = qpb - kk0 - 4 * g;
                float cfk = f_none ? 0.f : __builtin_amdgcn_exp2f(lf2 * (float)(qpf - PF0)) * dfa0;
                float cbk = b_none ? 0.f : __builtin_amdgcn_exp2f(lb2 * (float)(kk0 - qpb)) * dba0;
                if (clean) {
#pragma unroll
                    for (int kb = 0; kb < 4; ++kb) {
#pragma unroll
                        for (int r = 0; r < 4; ++r) s[kb][qs][r] *= (cfk * dfr[r] + cbk * dbr[r]);
                        cfk *= f16; cbk *= b16; }
                } else {
#pragma unroll
                    for (int kb = 0; kb < 4; ++kb) {
#pragma unroll
                        for (int r = 0; r < 4; ++r) { const float w1 = (kb * 16 + r <= tf) ? cfk * dfr[r] : 0.f, w2 = (kb * 16 + r >= tb) ? cbk * dbr[r] : 0.f; s[kb][qs][r] *= (w1 + w2); }
                        cfk *= f16; cbk *= b16; }
                }
            }
        } else {
            float mx[2];
#pragma unroll
            for (int qs = 0; qs < 2; ++qs) {
                float m0 = fmaxf(fmaxf(s[0][qs][0], s[0][qs][1]), fmaxf(s[0][qs][2], s[0][qs][3]));
#pragma unroll
                for (int kb = 1; kb < 4; ++kb) m0 = fmaxf(m0, fmaxf(fmaxf(s[kb][qs][0], s[kb][qs][1]), fmaxf(s[kb][qs][2], s[kb][qs][3])));
                { const unsigned u = __float_as_uint(m0); const auto r1 = __builtin_amdgcn_permlane16_swap(u, u, false, false); m0 = fmaxf(__uint_as_float(r1[0]), __uint_as_float(r1[1])); }
                { const unsigned u = __float_as_uint(m0); const auto r2 = __builtin_amdgcn_permlane32_swap(u, u, false, false); m0 = fmaxf(__uint_as_float(r2[0]), __uint_as_float(r2[1])); }
                mx[qs] = m0 * csc;
            }
            const bool need = (mx[0] - mrun[0] > 8.0f) || (mx[1] - mrun[1] > 8.0f);
            if (__builtin_amdgcn_ballot_w64(need) != 0ull) {
#pragma unroll
                for (int qs = 0; qs < 2; ++qs) {
                    const float mnew = fmaxf(mrun[qs], mx[qs]);
                    const float alpha = __builtin_amdgcn_exp2f(mrun[qs] - mnew);
                    mrun[qs] = mnew; lrun[qs] *= alpha;
#pragma unroll
                    for (int db = 0; db < NDB; ++db) O[db][qs] *= alpha;
                }
            }
#pragma unroll
            for (int qs = 0; qs < 2; ++qs) {
                float ps = 0.f; const float mr = mrun[qs];
#pragma unroll
                for (int kb = 0; kb < 4; ++kb)
#pragma unroll
                    for (int r = 0; r < 4; ++r) { const float pv = __builtin_amdgcn_exp2f(s[kb][qs][r] * csc - mr); s[kb][qs][r] = pv; ps += pv; }
                lrun[qs] += ps;
            }
        }
        bf16x8 pf[2][2];
#pragma unroll
        for (int qs = 0; qs < 2; ++qs)
#pragma unroll
            for (int j = 0; j < 2; ++j) {
                u32x4 pk; pk.x = pk_bf16(s[2 * j][qs][0], s[2 * j][qs][1]); pk.y = pk_bf16(s[2 * j][qs][2], s[2 * j][qs][3]);
                pk.z = pk_bf16(s[2 * j + 1][qs][0], s[2 * j + 1][qs][1]); pk.w = pk_bf16(s[2 * j + 1][qs][2], s[2 * j + 1][qs][3]);
                pf[qs][j] = __builtin_bit_cast(bf16x8, pk);
            }
#pragma unroll
        for (int db = 0; db < NDB; ++db) {
            if (db + 1 < NDB) { ATT_TR(vr[(db + 1) & 1], db + 1);
                asm volatile("s_waitcnt lgkmcnt(4)" : "+v"(vr[db & 1][0]), "+v"(vr[db & 1][1]), "+v"(vr[db & 1][2]), "+v"(vr[db & 1][3]) :: "memory"); }
            else asm volatile("s_waitcnt lgkmcnt(0)" : "+v"(vr[db & 1][0]), "+v"(vr[db & 1][1]), "+v"(vr[db & 1][2]), "+v"(vr[db & 1][3]) :: "memory");
            const bf16x8 vf0 = __builtin_shufflevector(vr[db & 1][0], vr[db & 1][1], 0, 1, 2, 3, 4, 5, 6, 7);
            const bf16x8 vf1 = __builtin_shufflevector(vr[db & 1][2], vr[db & 1][3], 0, 1, 2, 3, 4, 5, 6, 7);
#pragma unroll
            for (int qs = 0; qs < 2; ++qs) {
                O[db][qs] = __builtin_amdgcn_mfma_f32_16x16x32_bf16(vf0, pf[qs][0], O[db][qs], 0, 0, 0);
                O[db][qs] = __builtin_amdgcn_mfma_f32_16x16x32_bf16(vf1, pf[qs][1], O[db][qs], 0, 0, 0);
            }
        }
        if (t + 1 < nkt) ATT_STORE(buf ^ 1);
        __syncthreads();
    }
#undef ATT_TR
#undef ATT_LOAD
#undef ATT_STORE
    float linv[2] = {1.f, 1.f};
    if (KIND != 1) {
#pragma unroll
        for (int qs = 0; qs < 2; ++qs) { float lt = lrun[qs]; lt += __shfl_xor(lt, 16); lt += __shfl_xor(lt, 32); linv[qs] = 1.0f / lt; }
    }
    if (KIND == 2) {
#pragma unroll
        for (int qs = 0; qs < 2; ++qs) { bf16_t* op = P + (rowbase + qn0 + qs * 16 + lq) * QKVC + 3072 + head * 64 + 4 * g;
#pragma unroll
            for (int db = 0; db < NDB; ++db) { const f32x4 o = O[db][qs] * linv[qs]; u32x2 wv; wv.x = pk_bf16(o[0], o[1]); wv.y = pk_bf16(o[2], o[3]); if (!dummy) *(u32x2*)(op + db * 16) = wv; } }
    } else if (KIND == 1) {
        const float* ng = p.ret_norm_g + l * 128;
#pragma unroll
        for (int qs = 0; qs < 2; ++qs) {
            float ss = 0.f;
#pragma unroll
            for (int db = 0; db < NDB; ++db) { const f32x4 o = O[db][qs]; ss += o[0] * o[0] + o[1] * o[1] + o[2] * o[2] + o[3] * o[3]; }
            ss += __shfl_xor(ss, 16); ss += __shfl_xor(ss, 32);
            const float rn = rsqrtf(ss * (1.0f / 128.0f) + EPS);
            bf16_t* op = P + (rowbase + qn0 + qs * 16 + lq) * QKVC + 2560 + head * 128 + 4 * g;
#pragma unroll
            for (int db = 0; db < NDB; ++db) { const u32x2 gv = *(const u32x2*)(op + db * 16); const f32x4 gn = *(const f32x4*)(ng + db * 16 + 4 * g);
                const f32x4 o = O[db][qs] * rn * gn;
                u32x2 wv; wv.x = pk_bf16(o[0] * fast_silu(bf_lo(gv.x)), o[1] * fast_silu(bf_hi(gv.x))); wv.y = pk_bf16(o[2] * fast_silu(bf_lo(gv.y)), o[3] * fast_silu(bf_hi(gv.y)));
                if (!dummy) *(u32x2*)(op + db * 16) = wv; }
        }
    } else {
        float* X = (float*)lds;
        if (comp == 1) {
#pragma unroll
            for (int qs = 0; qs < 2; ++qs)
#pragma unroll
                for (int db = 0; db < NDB; ++db)
#pragma unroll
                    for (int r = 0; r < 4; ++r) X[(((w & 3) * 64) + (qs * NDB + db) * 4 + r) * 64 + lane] = O[db][qs][r] * linv[qs];
        }
        __syncthreads();
        if (comp == 0) {
            const float lam = misc[0], osc = 1.0f - misc[1];
            const float* ng = p.diff_norm_g + l * 128;
#pragma unroll
            for (int qs = 0; qs < 2; ++qs) {
                float ss = 0.f;
#pragma unroll
                for (int db = 0; db < NDB; ++db)
#pragma unroll
                    for (int r = 0; r < 4; ++r) { const float o = O[db][qs][r] * linv[qs] - lam * X[(((w & 3) * 64) + (qs * NDB + db) * 4 + r) * 64 + lane]; O[db][qs][r] = o; ss += o * o; }
                ss += __shfl_xor(ss, 16); ss += __shfl_xor(ss, 32);
                const float rn = rsqrtf(ss * (1.0f / 128.0f) + EPS) * osc;
                bf16_t* op = P + (rowbase + qn0 + qs * 16 + lq) * QKVC + head * 128 + 4 * g;
#pragma unroll
                for (int db = 0; db < NDB; ++db) { const f32x4 gn = *(const f32x4*)(ng + db * 16 + 4 * g); const f32x4 o = O[db][qs] * rn * gn;
                    u32x2 wv; wv.x = pk_bf16(o[0], o[1]); wv.y = pk_bf16(o[2], o[3]); if (!dummy) *(u32x2*)(op + db * 16) = wv; }
            }
        }
        __syncthreads();
    }
}

__device__ __forceinline__ void attn_phase(const Params& p, unsigned char* lds, int l, int dummy) {
    bf16_t* P = (bf16_t*)(p.ws + WS_P);
    const int G = (int)gridDim.x, bx = (int)blockIdx.x;
    const int vcu = (G % 8 == 0) ? (bx % 8) * (G / 8) + bx / 8 : bx;
    const bool last = (l == DEPTH - 1);
    const int nA = last ? 1024 : 1152, nB = last ? 512 : 576, nC = last ? 1024 : 1152;
#ifndef AKMASK
#define AKMASK 7
#endif
    int idx = vcu;
    for (; idx < nA; idx += G) {
        if (!(AKMASK & 1)) continue;
        const int ic = idx >= 1024, j = idx - 1024;
        attn_item<0>(lds, P, p, l, ic ? j >> 3 : idx >> 6, ic ? (j >> 1) & 3 : (idx >> 4) & 3, ic ? j & 1 : idx & 15, ic, dummy);
    }
    for (; idx < nA + nB; idx += G) {
        if (!(AKMASK & 2)) continue;
        const int j = idx - nA;
        const int ic = j >= 512, jj = j - 512;
        attn_item<1>(lds, P, p, l, ic ? jj >> 2 : j >> 5, ic ? jj & 3 : (j >> 3) & 3, ic ? 0 : j & 7, ic, dummy);
    }
    for (; idx < nA + nB + nC; idx += G) {
        if (!(AKMASK & 4)) continue;
        const int j = idx - nA - nB;
        const int ic = j >= 1024, jj = j - 1024;
        attn_item<2>(lds, P, p, l, ic ? jj >> 3 : j >> 6, ic ? jj & 7 : (j >> 3) & 7, ic ? 0 : j & 7, ic, dummy);
    }
}

#define XB_TMO      128
#define XB_XCNT(j)  (256  + 64 * (j))
#define XB_XSUB(j)  (1280 + 64 * (j))
#define XB_XGEN(j)  (2304 + 64 * (j))
#define XB_TOP      3328
#define XB_TOPGEN   3392
#define XCD_BAR_WORDS 3456
#define XB_SPIN_CAP (1u << 18)
__device__ __forceinline__ unsigned xb_ld(unsigned* p)              { return __hip_atomic_load(p, __ATOMIC_RELAXED, __HIP_MEMORY_SCOPE_AGENT); }
__device__ __forceinline__ unsigned xb_add(unsigned* p, unsigned v) { return __hip_atomic_fetch_add(p, v, __ATOMIC_RELAXED, __HIP_MEMORY_SCOPE_AGENT); }
__device__ __forceinline__ unsigned xb_xcc_id() { return (unsigned)__builtin_amdgcn_s_getreg((3 << 11) | 20) & 0xFu; }
#define XB_SPIN(cond, bar) do { unsigned _sp = 0; while (cond) { __builtin_amdgcn_s_sleep(1); \
    if ((++_sp & 255u) == 0u) { if (xb_ld(&(bar)[XB_TMO])) break; if (_sp > XB_SPIN_CAP) { atomicAdd(&(bar)[XB_TMO], 1u); break; } } } } while (0)
struct XcdBarrier { unsigned* bar; unsigned x; volatile LAS unsigned* st; };
__device__ __forceinline__ XcdBarrier xcd_barrier_post(unsigned* bar, volatile LAS unsigned* st) {
    XcdBarrier b; b.bar = bar; b.x = xb_xcc_id(); b.st = st;
    if (threadIdx.x == 0) (void)xb_add(&bar[XB_XCNT(b.x)], 1u);
    return b;
}
__device__ __forceinline__ void xcd_barrier_complete(unsigned* bar, unsigned x, unsigned& nloc, unsigned& nx) {
    const unsigned G = gridDim.x * gridDim.y * gridDim.z;
    unsigned sum, cnt, mine, sp = 0u;
    for (;;) {
        sum = 0u; cnt = 0u; mine = 0u;
#pragma unroll
        for (unsigned j = 0; j < 16; ++j) { const unsigned c = xb_ld(&bar[XB_XCNT(j)]); sum += c; cnt += (c > 0u) ? 1u : 0u; mine = (j == x) ? c : mine; }
        if (sum == G) break;
        __builtin_amdgcn_s_sleep(1);
        if ((++sp & 255u) == 0u) { if (xb_ld(&bar[XB_TMO])) break; if (sp > XB_SPIN_CAP) { atomicAdd(&bar[XB_TMO], 1u); break; } }
    }
    nloc = mine > 0u ? mine : 1u; nx = cnt > 0u ? cnt : 1u;
}
__device__ __forceinline__ void xcd_barrier(const XcdBarrier& b) {
    asm volatile("s_waitcnt vmcnt(0)" ::: "memory");
    __syncthreads();
    if (threadIdx.x == 0) {
        unsigned* bar = b.bar;
        __builtin_amdgcn_s_waitcnt(0);
        unsigned nloc = b.st[0], nx = b.st[1];
        if (nloc == 0u) { xcd_barrier_complete(bar, b.x, nloc, nx); b.st[0] = nloc; b.st[1] = nx; }
        const unsigned old = xb_add(&bar[XB_XSUB(b.x)], 1u);
        const unsigned gen = old / nloc;
        if (old + 1u == (gen + 1u) * nloc) {
            __builtin_amdgcn_fence(__ATOMIC_RELEASE, "agent");
            asm volatile("s_waitcnt vmcnt(0)" ::: "memory");
            const unsigned og = xb_add(&bar[XB_TOP], 1u);
            const unsigned tg = og / nx;
            if (og + 1u == (tg + 1u) * nx) xb_add(&bar[XB_TOPGEN], 1u);
            else XB_SPIN(xb_ld(&bar[XB_TOPGEN]) == tg, bar);
            __builtin_amdgcn_fence(__ATOMIC_ACQUIRE, "agent");
            xb_add(&bar[XB_XGEN(b.x)], 1u);
            asm volatile("s_waitcnt vmcnt(0)" ::: "memory");
        } else {
            XB_SPIN(xb_ld(&bar[XB_XGEN(b.x)]) == gen, bar);
            __builtin_amdgcn_fence(__ATOMIC_ACQUIRE, "agent");
            asm volatile("s_waitcnt vmcnt(0)" ::: "memory");
        }
    }
    __syncthreads();
}

constexpr int NPH = 2 + 12 * DEPTH;

__device__ __forceinline__ void run_phase(const Params& p, unsigned char* lds, int ph, int dummy) {
    float* lf = (float*)lds;
    LAS unsigned char* ldsl = (LAS unsigned char*)lds;
    bf16_t* P = (bf16_t*)(p.ws + WS_P);
    bf16_t* Y = (bf16_t*)(p.ws + WS_Y);
    unsigned char* G8 = p.ws + WS_G8;
#ifndef PHMASK
#define PHMASK 0xffff
#endif
    if (ph == 0 && (PHMASK & 1)) {
        const int total = 288 + 1 + CONV_FFN_TILES + CONV_MIX_TILES;
        for (int it = blockIdx.x; it < total; it += gridDim.x) {
            if (it < 288) mod_item(p, lf, it);
            else if (it == 288) misc_item(p);
            else if (it < 289 + CONV_FFN_TILES) conv_ffn(p, lf, 0, 0, it - 289);
            else conv_mix(p, lf, 0, it - 289 - CONV_FFN_TILES);
        }
        return;
    }
    if (ph == 0) return;
    if (ph == 1) { if (PHMASK & 2) ephase_rows(p, true, 0, 0, 0.f, Y, 0, 0, false, dummy); return; }
    const int l = (ph - 2) / 12, k = (ph - 2) % 12;
    const bool last = (l == DEPTH - 1);
    switch (k) {
    case 0: case 9: if (PHMASK & 4) {
        const int lat = (k == 9 && last) ? 1 : 0;
        pg8::Gemm g{Y, (const bf16_t*)(p.ws + WS_WFI), DM, DM, DM, 0};
        pg8::Order S; S.init(lat ? 128 : 144, 22, lat, 1, DM, DM);
        pg8::EpiSwiglu E{P};
        pg8::gemm_phase<pg8::EpiSwiglu>(ldsl, g, S, E);
    } break;
    case 1: case 7: case 10: if (PHMASK & 8) {
        const int lat = (k != 1 && last) ? 1 : 0;
        pg8::Gemm g; pg8::EpiPlain E;
        if (k == 7) { g = pg8::Gemm{Y, (const bf16_t*)(p.ws + WS_WMO), DM, DM, DM, 0}; E = pg8::EpiPlain{P, DM}; }
        else { g = pg8::Gemm{P, (const bf16_t*)(p.ws + WS_WFO), DFF, DFF, DFF, 0}; E = pg8::EpiPlain{Y, DM}; }
        pg8::Order S; S.init(lat ? 128 : 144, 4, lat, 1, g.lda, g.ldb);
        pg8::gemm_phase<pg8::EpiPlain>(ldsl, g, S, E);
    } break;
    case 2: case 8: case 11: if (PHMASK & 2) {
        if (k == 2) { for (int it = blockIdx.x; it < CONV_FFN_TILES; it += gridDim.x) conv_ffn(p, lf, l, 1, it); }
        else if (k == 8) { if (!last) for (int it = blockIdx.x; it < CONV_MIX_TILES; it += gridDim.x) conv_mix(p, lf, l + 1, it); }
        else { if (!last) for (int it = blockIdx.x; it < CONV_FFN_TILES; it += gridDim.x) conv_ffn(p, lf, l + 1, 0, it); }
        if (k == 2) ephase_rows(p, false, l, 0, 0.5f, Y, l, 1, false, dummy);
        else if (k == 8) ephase_rows(p, false, l, 1, 1.0f, P, l, 2, last, dummy);
        else ephase_rows(p, false, l, 2, 0.5f, Y, last ? l : l + 1, last ? -1 : 0, last, dummy);
    } break;
    case 3: if (PHMASK & 16) {
        pg8::Gemm g{Y, (const bf16_t*)(p.ws + WS_WMI), DM, DM, DM, 0};
        pg8::Order S; S.init(144, 27, 0, 1, DM, DM);
        pg8::EpiQkvGate E{P, G8, p.b_gate + (size_t)l * GATEC};
        pg8::gemm_phase<pg8::EpiQkvGate>(ldsl, g, S, E);
    } break;
    case 4: if (PHMASK & 32) rope_phase(p, l, dummy); break;
    case 5: if (PHMASK & 64) attn_phase(p, lds, l, dummy); break;
    case 6: if (PHMASK & 128) {
        const int lat = last ? 1 : 0;
        pg8::Gemm g{P, (const bf16_t*)(p.ws + WS_WMB), QKVC, 512, 512, 0};
        pg8::Order S; S.init(lat ? 128 : 144, 4, lat, 3, QKVC, 512, 2560 * 2, 3072 * 2, (size_t)DM * 512 * 2);
        pg8::EpiMerge E{Y, G8};
        pg8::gemm_phase<pg8::EpiMerge>(ldsl, g, S, E);
    } break;
    }
}

__global__ void __launch_bounds__(NTHREADS) mk_fwd(Params p) {
    extern __shared__ __attribute__((aligned(16))) unsigned char lds[];
    volatile LAS unsigned* st = (volatile LAS unsigned*)((LAS unsigned char*)lds + LDS_MAIN);
    const bool multi = (p.ph_hi - p.ph_lo) > 1;
    XcdBarrier bar; bar.bar = (unsigned*)(p.ws + WS_BAR); bar.x = 0; bar.st = st;
    if (multi) {
        if (threadIdx.x < 4) st[threadIdx.x] = 0u;
        __syncthreads();
        bar = xcd_barrier_post((unsigned*)(p.ws + WS_BAR), st);
    }
    for (int ph = p.ph_lo; ph < p.ph_hi; ++ph) {
        int nrep = 1;
        if (PROBE_DUP) {
            const int k = ph < 2 ? -1 : (ph - 2) % 12;
            const int kind = ph == 0 ? 1 : (ph == 1 || k == 2 || k == 8 || k == 11) ? 2 : (k == 0 || k == 9) ? 4 : (k == 1 || k == 7 || k == 10) ? 8 : k == 3 ? 16 : k == 4 ? 32 : k == 5 ? 64 : 128;
            if ((PROBE_DUP & kind) && p.probe) nrep = 2;
        }
        for (int rep = 0; rep < nrep; ++rep) run_phase(p, lds, ph, rep + 1 < nrep ? 1 : 0);
        if (ph + 1 < p.ph_hi) {
            if (ph == p.ph_lo) cg::this_grid().sync();
            else xcd_barrier(bar);
            if ((PROBE_DUP & 256) && p.probe) xcd_barrier(bar);
        }
    }
}

extern "C" void kernel_launch(void* const* d_in, const int* in_sizes, int n_in, void* d_out, int out_size, void* d_ws, size_t ws_size, hipStream_t stream) {
    static int grid = 0;
    if (grid == 0) {
        if (ws_size < WS_END) { fprintf(stderr, "kernel_launch: workspace too small: %zu < %zu\n", ws_size, (size_t)WS_END); grid = -1; return; }
        int dev = 0, cus = 0, per_cu = 0;
        hipGetDevice(&dev);
        hipDeviceGetAttribute(&cus, hipDeviceAttributeMultiprocessorCount, dev);
        if (hipFuncSetAttribute((const void*)mk_fwd, hipFuncAttributeMaxDynamicSharedMemorySize, LDS_BYTES) != hipSuccess) { fprintf(stderr, "kernel_launch: hipFuncSetAttribute failed\n"); grid = -1; return; }
        if (hipOccupancyMaxActiveBlocksPerMultiprocessor(&per_cu, (const void*)mk_fwd, NTHREADS, LDS_BYTES) != hipSuccess || per_cu < 1) { fprintf(stderr, "kernel_launch: occupancy query gave %d\n", per_cu); per_cu = 1; }
        (void)hipGetLastError();
        grid = cus * 1;
        if (grid <= 0) grid = 256;
    }
    if (grid < 0) return;
    Params p{};
    p.x = (const float*)d_in[0]; p.c = (const float*)d_in[1]; p.ctx = (const float*)d_in[2]; p.c_ctx = (const float*)d_in[3];
    p.w_mod = (const float*)d_in[4]; p.b_mod = (const float*)d_in[5]; p.norm_g = (const float*)d_in[6]; p.w_ffn_in = (const float*)d_in[7];
    p.w_ffn_out = (const float*)d_in[8]; p.w_in = (const float*)d_in[9]; p.b_gate = (const float*)d_in[10]; p.diff_lambda = (const float*)d_in[11];
    p.diff_norm_g = (const float*)d_in[12]; p.ret_logit = (const float*)d_in[13]; p.ret_norm_g = (const float*)d_in[14]; p.qk_norm_g = (const float*)d_in[15];
    p.w_branch = (const float*)d_in[16]; p.w_out = (const float*)d_in[17];
    p.out = (float*)d_out; p.ws = (unsigned char*)d_ws; p.probe = PROBE_DUP ? 1 : 0;
#if MK_PER_PHASE
    for (int ph = 0; ph < NPH; ++ph) {
        p.ph_lo = ph; p.ph_hi = ph + 1;
        hipLaunchKernelGGL(mk_fwd, dim3(grid), dim3(NTHREADS), LDS_BYTES, stream, p);
    }
#else
    p.ph_lo = 0; p.ph_hi = NPH;
    if (hipMemsetAsync((char*)d_ws + WS_BAR, 0, 16384, stream) != hipSuccess) { fprintf(stderr, "kernel_launch: memset of barrier words failed\n"); return; }
    void* args[] = {&p};
    hipError_t e = hipLaunchCooperativeKernel((const void*)mk_fwd, dim3(grid), dim3(NTHREADS), args, LDS_BYTES, stream);
    if (e != hipSuccess) fprintf(stderr, "cooperative launch failed: %s (grid %d)\n", hipGetErrorString(e), grid);
#endif
}
```

```cpp
#include <hip/hip_runtime.h>
#include <hip/hip_cooperative_groups.h>
#include <cstdio>
#include <cstdint>
namespace cg = cooperative_groups;

#ifndef PROBE_DUP
#define PROBE_DUP 0
#endif
#ifndef PROBE_AMP
#define PROBE_AMP 0
#endif
#ifndef ATT_FORCE
#define ATT_FORCE 0
#endif
#ifndef ATT_SKEW
#define ATT_SKEW 1
#endif
#ifndef MK_PER_PHASE
#define MK_PER_PHASE 0
#endif

#define LAS __attribute__((address_space(3)))
typedef unsigned short bf16_t;
typedef short bf16x8 __attribute__((ext_vector_type(8)));
typedef short s16x4 __attribute__((ext_vector_type(4)));
typedef float f32x4 __attribute__((ext_vector_type(4)));
typedef float f32x2 __attribute__((ext_vector_type(2)));
typedef unsigned u32x4 __attribute__((ext_vector_type(4)));
typedef unsigned u32x2 __attribute__((ext_vector_type(2)));
typedef __bf16 bf16v2 __attribute__((ext_vector_type(2)));

constexpr int DM = 1024, NB = 16, SEQ = 2048, CTXL = 256, TPB = 2304, NT = NB * TPB, DFF = 2816, DEPTH = 2;
constexpr int QKVC = 3840, GATEC = 3072, INC = 6912, MODC = 9216;
constexpr float EPS = 1e-6f;
constexpr int NTHREADS = 512;
constexpr int LDS_MAIN = 131072;
constexpr int LDS_BYTES = LDS_MAIN + 16;

constexpr size_t WS_P    = 0;
constexpr size_t WS_G8   = WS_P + (size_t)NT * QKVC * 2;
constexpr size_t WS_Y    = WS_G8 + (size_t)NT * GATEC;
constexpr size_t WS_HC   = WS_Y + (size_t)NT * DM * 2;
constexpr size_t WS_WFI  = WS_HC + (size_t)NB * CTXL * DM * 4;
constexpr size_t WS_WFO  = WS_WFI + (size_t)2 * DFF * DM * 2;
constexpr size_t WS_WMI  = WS_WFO + (size_t)DM * DFF * 2;
constexpr size_t WS_WMB  = WS_WMI + (size_t)INC * DM * 2;
constexpr size_t WS_WMO  = WS_WMB + (size_t)3 * DM * 512 * 2;
constexpr size_t WS_MOD  = WS_WMO + (size_t)DM * DM * 2;
constexpr size_t WS_ROPE = WS_MOD + (size_t)DEPTH * 17 * MODC * 4;
constexpr size_t WS_MISC = WS_ROPE + 64 * 16 * 8;
constexpr size_t WS_BAR  = WS_MISC + 1024;
constexpr size_t WS_END  = WS_BAR + 16384;
constexpr size_t WS_PART = WS_P + (size_t)208 * 1024 * 1024;
constexpr size_t WS_RSU  = WS_Y;
constexpr size_t WS_RST  = WS_Y + (size_t)40 * 1024 * 1024;

struct Params {
    const float *x, *c, *ctx, *c_ctx, *w_mod, *b_mod, *norm_g, *w_ffn_in, *w_ffn_out, *w_in, *b_gate,
                *diff_lambda, *diff_norm_g, *ret_logit, *ret_norm_g, *qk_norm_g, *w_branch, *w_out;
    float* out; unsigned char* ws; int ph_lo, ph_hi, probe, pad;
};

__device__ __forceinline__ int opaque_tid() { int t = (int)threadIdx.x; asm volatile("" : "+v"(t)); return t; }
__device__ __forceinline__ int opaque_bid() { int t = (int)blockIdx.x; asm volatile("" : "+s"(t)); return t; }
__device__ __forceinline__ unsigned pk_bf16(float lo, float hi) { f32x2 v = {lo, hi}; bf16v2 r = __builtin_convertvector(v, bf16v2); return __builtin_bit_cast(unsigned, r); }
__device__ __forceinline__ float bf_lo(unsigned u) { return __uint_as_float(u << 16); }
__device__ __forceinline__ float bf_hi(unsigned u) { return __uint_as_float(u & 0xffff0000u); }
__device__ __forceinline__ float wave_sum(float v) {
    v += __shfl_xor(v, 32); v += __shfl_xor(v, 16); v += __shfl_xor(v, 8); v += __shfl_xor(v, 4); v += __shfl_xor(v, 2); v += __shfl_xor(v, 1); return v; }
__device__ __forceinline__ float fast_sigmoid(float a) { return __builtin_amdgcn_rcpf(1.0f + __builtin_amdgcn_exp2f(a * -1.4426950408889634f)); }
__device__ __forceinline__ float fast_silu(float a) { return a * fast_sigmoid(a); }

namespace pg8 {
constexpr int BM = 256, BK = 64, HALF = 128, HTB = HALF * BK * 2, STAGE_BYTES = 8 * HTB, NXCD = 8, WGM = 8;
__device__ __forceinline__ int lds_byte(int r, int c) { const int st = (r >> 4) * 2 + (c >> 5), rr = r & 15, cc = c & 31, ob = rr * 64 + cc * 2; return st * 1024 + (ob ^ (((ob >> 9) & 1) << 5)); }
__device__ __forceinline__ void stage_rc(int b, int& R, int& C) { const int st = b / 1024, sb = b % 1024, swz = sb ^ (((sb >> 9) & 1) << 5); R = (st >> 1) * 16 + swz / 64; C = (st & 1) * 32 + (swz % 64) / 2; }
__device__ __forceinline__ int perm32(int rho) { const int n = rho >> 4, i = rho & 15; return 8 * (i >> 2) + 4 * n + (i & 3); }

struct Unit { int pm, pn, br, nt; size_t aoff, boff; };
struct Gemm { const bf16_t* A; const bf16_t* Bt; int lda, ldb, K, pad; };

struct Order {
    int nM, nN, nwg, G, c, latent_only, reps, extra, xmode, ntfull, nchunks, pad;
    size_t a_tile, b_tile, a_rep0, a_rep1, a_rep2, b_rep;
    __device__ __forceinline__ void init(int nM_, int nN_, int latent_only_, int reps_, int lda, int ldb, size_t ar1 = 0, size_t ar2 = 0, size_t brep = 0) {
        nM = nM_; nN = nN_; nwg = nM * nN; G = (int)gridDim.x; c = opaque_bid(); latent_only = latent_only_; reps = reps_; extra = 0; xmode = 1; ntfull = 0; nchunks = 0; pad = 0;
        a_tile = (size_t)BM * lda * 2; b_tile = (size_t)BM * ldb * 2; a_rep0 = 0; a_rep1 = ar1; a_rep2 = ar2 - ar1; b_rep = brep;
    }
    __device__ __forceinline__ bool next(int i, Unit& u) const {
        int it = i, br = 0;
        if (reps == 3) { it = i / 3; br = i - it * 3; }
        const long L = (long)it * G + c; if (L >= nwg + extra) return false;
        if (L >= nwg) {
            const int j = (int)(L - nwg);
            if (xmode == 2) {
                const int cu = j >> 2, part = j & 3, base = nchunks >> 2, rem = nchunks & 3;
                const int start = part * base + (part < rem ? part : rem), size = base + (part < rem ? 1 : 0);
                u.pm = (cu >> 2) * 9 + 8; u.pn = cu & 3; u.br = part + 1; u.nt = size * 2;
                u.aoff = (size_t)u.pm * a_tile + (size_t)start * 256; u.boff = (size_t)u.pn * b_tile + (size_t)start * 256; return true;
            }
            u.pm = (j >> 3) * 9 + 8; u.pn = (int)((0xE9875432u >> (4 * (j & 7))) & 15u); u.br = 0; u.nt = ntfull;
            u.aoff = (size_t)u.pm * a_tile; u.boff = (size_t)u.pn * b_tile; return true;
        }
        int wgid = (int)L; { const int q = nwg / NXCD, r = nwg % NXCD, xcd = wgid % NXCD, off = wgid / NXCD; wgid = (xcd < r ? xcd * (q + 1) : r * (q + 1) + (xcd - r) * q) + off; }
        const int nig = WGM * nN, gid = wgid / nig, fm = gid * WGM, gsz = (nM - fm) < WGM ? (nM - fm) : WGM;
        const int pmv = fm + ((wgid % nig) % gsz); u.pn = (wgid % nig) / gsz;
        u.pm = latent_only ? (pmv >> 3) * 9 + (pmv & 7) : pmv; u.br = br; u.nt = ntfull;
        u.aoff = (size_t)u.pm * a_tile + (size_t)(br > 0 ? 1 : 0) * (a_rep1 + (size_t)(br - 1) * a_rep2);
        u.boff = (size_t)u.pn * b_tile + (size_t)br * b_rep;
        return true;
    }
};


struct EpiPlain {
    bf16_t* O; int ldc; bf16_t* Opart;
    __device__ __forceinline__ void operator()(const f32x4 (&acc)[2][2][4][2], const Unit& u, int wr, int wc, int fr, int fq) const {
        const int col0 = u.pn * BM + wc * 32 + 8 * fq;
        bf16_t* base = O + (size_t)(u.pm * BM + wr * 64 + fr) * ldc + col0;
        if (u.br > 0) base = Opart + ((size_t)(u.br - 1) * (NB * CTXL) + (size_t)((u.pm / 9) * BM + wr * 64 + fr)) * DM + col0;
#pragma unroll
        for (int ai = 0; ai < 2; ++ai)
#pragma unroll
            for (int m = 0; m < 4; ++m) { bf16_t* rowp = base + (size_t)(ai * HALF + m * 16) * ldc;
#pragma unroll
                for (int bj = 0; bj < 2; ++bj) { const f32x4 v0 = acc[ai][bj][m][0], v1 = acc[ai][bj][m][1];
                    u32x4 w; w.x = pk_bf16(v0[0], v0[1]); w.y = pk_bf16(v0[2], v0[3]); w.z = pk_bf16(v1[0], v1[1]); w.w = pk_bf16(v1[2], v1[3]);
                    *(u32x4*)(rowp + bj * HALF) = w; } }
    }
};
struct EpiSwiglu {
    bf16_t* O;
    __device__ __forceinline__ void operator()(const f32x4 (&acc)[2][2][4][2], const Unit& u, int wr, int wc, int fr, int fq) const {
        const int row0 = u.pm * BM + wr * 64 + fr, col0 = u.pn * HALF + wc * 32 + 8 * fq;
#pragma unroll
        for (int ai = 0; ai < 2; ++ai)
#pragma unroll
            for (int m = 0; m < 4; ++m) { bf16_t* rowp = O + (size_t)(row0 + ai * HALF + m * 16) * DFF + col0;
                const f32x4 a0 = acc[ai][0][m][0], a1 = acc[ai][0][m][1], g0 = acc[ai][1][m][0], g1 = acc[ai][1][m][1];
                u32x4 w; w.x = pk_bf16(fast_silu(a0[0]) * g0[0], fast_silu(a0[1]) * g0[1]); w.y = pk_bf16(fast_silu(a0[2]) * g0[2], fast_silu(a0[3]) * g0[3]);
                w.z = pk_bf16(fast_silu(a1[0]) * g1[0], fast_silu(a1[1]) * g1[1]); w.w = pk_bf16(fast_silu(a1[2]) * g1[2], fast_silu(a1[3]) * g1[3]);
                *(u32x4*)rowp = w; }
    }
};
struct EpiQkvGate {
    bf16_t* P; unsigned char* G8; const float* bgate; const f32x2* rope; const float* knorm;
    __device__ __forceinline__ void operator()(const f32x4 (&acc)[2][2][4][2], const Unit& u, int wr, int wc, int fr, int fq) const {
        const int row0 = u.pm * BM + wr * 64 + fr;
        if (u.pn == 2 || u.pn == 3 || u.pn == 7 || u.pn == 14) {
            const bool lat = (u.pm % 9) != 8;
            const bool isv = (u.pn == 14) && (wc >= 2), cnorm = (u.pn == 14) && (wc < 2);
            const int c1 = isv ? 3712 + (wc - 2) * 32 + 8 * fq : (u.pn == 14 ? 3584 : u.pn * BM) + wc * 64 + 8 * fq, c2 = isv ? c1 + 64 : c1 + 32;
#pragma unroll
            for (int ai = 0; ai < 2; ++ai)
#pragma unroll
                for (int m = 0; m < 4; ++m) { const int row = row0 + ai * HALF + m * 16; bf16_t* rowp = P + (size_t)row * QKVC;
                    f32x4 a0 = acc[ai][0][m][0], a1 = acc[ai][0][m][1], b0 = acc[ai][1][m][0], b1 = acc[ai][1][m][1];
                    if (!isv) {
                        if (cnorm) {
                            float ss = 0.f;
#pragma unroll
                            for (int j = 0; j < 4; ++j) ss += a0[j] * a0[j] + a1[j] * a1[j] + b0[j] * b0[j] + b1[j] * b1[j];
                            ss += __shfl_xor(ss, 16); ss += __shfl_xor(ss, 32);
                            const float r = rsqrtf(ss * (1.0f / 64.0f) + EPS);
                            const f32x4 g0 = *(const f32x4*)(knorm + 8 * fq), g1 = *(const f32x4*)(knorm + 8 * fq + 4), g2 = *(const f32x4*)(knorm + 32 + 8 * fq), g3 = *(const f32x4*)(knorm + 36 + 8 * fq);
                            a0 *= r * g0; a1 *= r * g1; b0 *= r * g2; b1 *= r * g3;
                        }
                        if (lat) {
                            const int n = row % TPB; const int pos = (fq < 2) ? (n >> 6) : (n & 63);
                            const f32x4* cs = (const f32x4*)(rope + pos * 16 + (fq & 1) * 8);
                            const f32x4 t0 = cs[0], t1 = cs[1], t2 = cs[2], t3 = cs[3];
                            const f32x4 co0 = (f32x4){t0[0], t0[2], t1[0], t1[2]}, si0 = (f32x4){t0[1], t0[3], t1[1], t1[3]};
                            const f32x4 co1 = (f32x4){t2[0], t2[2], t3[0], t3[2]}, si1 = (f32x4){t2[1], t2[3], t3[1], t3[3]};
                            const f32x4 x0 = a0 * co0 - b0 * si0, y0 = a0 * si0 + b0 * co0, x1 = a1 * co1 - b1 * si1, y1 = a1 * si1 + b1 * co1;
                            a0 = x0; b0 = y0; a1 = x1; b1 = y1;
                        }
                    }
                    u32x4 w1, w2; w1.x = pk_bf16(a0[0], a0[1]); w1.y = pk_bf16(a0[2], a0[3]); w1.z = pk_bf16(a1[0], a1[1]); w1.w = pk_bf16(a1[2], a1[3]);
                    w2.x = pk_bf16(b0[0], b0[1]); w2.y = pk_bf16(b0[2], b0[3]); w2.z = pk_bf16(b1[0], b1[1]); w2.w = pk_bf16(b1[2], b1[3]);
                    *(u32x4*)(rowp + c1) = w1; *(u32x4*)(rowp + c2) = w2; }
        } else if (u.pn < 15) {
            const int col0 = u.pn * BM + wc * 32 + 8 * fq;
#pragma unroll
            for (int ai = 0; ai < 2; ++ai)
#pragma unroll
                for (int m = 0; m < 4; ++m) { bf16_t* rowp = P + (size_t)(row0 + ai * HALF + m * 16) * QKVC + col0;
#pragma unroll
                    for (int bj = 0; bj < 2; ++bj) { const f32x4 v0 = acc[ai][bj][m][0], v1 = acc[ai][bj][m][1];
                        u32x4 w; w.x = pk_bf16(v0[0], v0[1]); w.y = pk_bf16(v0[2], v0[3]); w.z = pk_bf16(v1[0], v1[1]); w.w = pk_bf16(v1[2], v1[3]);
                        *(u32x4*)(rowp + bj * HALF) = w; } }
        } else {
            const int col0 = (u.pn - 15) * BM + wc * 64 + 16 * fq;
            f32x4 bv[2][2];
#pragma unroll
            for (int bj = 0; bj < 2; ++bj)
#pragma unroll
                for (int n = 0; n < 2; ++n) bv[bj][n] = *(const f32x4*)(bgate + col0 + bj * 8 + 4 * n);
#pragma unroll
            for (int ai = 0; ai < 2; ++ai)
#pragma unroll
                for (int m = 0; m < 4; ++m) { unsigned char* rowp = G8 + (size_t)(row0 + ai * HALF + m * 16) * GATEC + col0;
                    unsigned wq[4];
#pragma unroll
                    for (int bj = 0; bj < 2; ++bj)
#pragma unroll
                        for (int n = 0; n < 2; ++n) { const f32x4 v = acc[ai][bj][m][n] + bv[bj][n]; unsigned q[4];
#pragma unroll
                            for (int j = 0; j < 4; ++j) q[j] = max(1u, (unsigned)__float2uint_rn(fast_sigmoid(v[j]) * 255.0f));
                            wq[bj * 2 + n] = q[0] | (q[1] << 8) | (q[2] << 16) | (q[3] << 24); }
                    *(u32x4*)rowp = (u32x4){wq[0], wq[1], wq[2], wq[3]}; }
        }
    }
};
struct EpiMerge {
    bf16_t* O; const unsigned char* G8;
    __device__ __forceinline__ void hook(f32x4 (&acc)[2][2][4][2], const Unit& u, int sg, int wr, int wc, int fr, int fq) const {
        const int row0 = u.pm * BM + wr * 64 + fr, col0 = u.pn * BM + wc * 32 + 8 * fq;
        const unsigned char* gbase = G8 + (size_t)row0 * GATEC + (sg - 1) * DM + col0;
#pragma unroll
        for (int ai = 0; ai < 2; ++ai)
#pragma unroll
            for (int mp = 0; mp < 2; ++mp) {
                u32x2 qa[2][2], qb[2][2];
#pragma unroll
                for (int mm = 0; mm < 2; ++mm) { const unsigned char* gp = gbase + (size_t)(ai * HALF + (mp * 2 + mm) * 16) * GATEC;
#pragma unroll
                    for (int bj = 0; bj < 2; ++bj) { qa[mm][bj] = *(const u32x2*)(gp + bj * HALF); qb[mm][bj] = *(const u32x2*)(gp + DM + bj * HALF); } }
#pragma unroll
                for (int mm = 0; mm < 2; ++mm)
#pragma unroll
                    for (int bj = 0; bj < 2; ++bj) { const u32x2 a = qa[mm][bj], b = qb[mm][bj]; const int m = mp * 2 + mm;
                        f32x4 r0, r1;
                        r0[0] = (float)(a.x & 255u) * __builtin_amdgcn_rcpf((float)(b.x & 255u)); r0[1] = (float)((a.x >> 8) & 255u) * __builtin_amdgcn_rcpf((float)((b.x >> 8) & 255u));
                        r0[2] = (float)((a.x >> 16) & 255u) * __builtin_amdgcn_rcpf((float)((b.x >> 16) & 255u)); r0[3] = (float)(a.x >> 24) * __builtin_amdgcn_rcpf((float)(b.x >> 24));
                        r1[0] = (float)(a.y & 255u) * __builtin_amdgcn_rcpf((float)(b.y & 255u)); r1[1] = (float)((a.y >> 8) & 255u) * __builtin_amdgcn_rcpf((float)((b.y >> 8) & 255u));
                        r1[2] = (float)((a.y >> 16) & 255u) * __builtin_amdgcn_rcpf((float)((b.y >> 16) & 255u)); r1[3] = (float)(a.y >> 24) * __builtin_amdgcn_rcpf((float)(b.y >> 24));
                        acc[ai][bj][m][0] *= r0; acc[ai][bj][m][1] *= r1; }
                asm volatile("" ::: "memory");
            }
    }
    __device__ __forceinline__ void operator()(const f32x4 (&acc)[2][2][4][2], const Unit& u, int wr, int wc, int fr, int fq) const {
        const int row0 = u.pm * BM + wr * 64 + fr, col0 = u.pn * BM + wc * 32 + 8 * fq;
        const float s = 1.0f / 255.0f;
#pragma unroll
        for (int ai = 0; ai < 2; ++ai) {
            u32x2 gq[4][2];
#pragma unroll
            for (int m = 0; m < 4; ++m) { const size_t r = (size_t)(row0 + ai * HALF + m * 16);
#pragma unroll
                for (int bj = 0; bj < 2; ++bj) gq[m][bj] = *(const u32x2*)(G8 + r * GATEC + 2 * DM + col0 + bj * HALF); }
#pragma unroll
            for (int m = 0; m < 4; ++m) { const size_t r = (size_t)(row0 + ai * HALF + m * 16);
#pragma unroll
                for (int bj = 0; bj < 2; ++bj) { const f32x4 v0 = acc[ai][bj][m][0], v1 = acc[ai][bj][m][1]; const u32x2 g = gq[m][bj];
                    float o[8];
                    o[0] = v0[0] * (s * (float)(g.x & 255u)); o[1] = v0[1] * (s * (float)((g.x >> 8) & 255u));
                    o[2] = v0[2] * (s * (float)((g.x >> 16) & 255u)); o[3] = v0[3] * (s * (float)(g.x >> 24));
                    o[4] = v1[0] * (s * (float)(g.y & 255u)); o[5] = v1[1] * (s * (float)((g.y >> 8) & 255u));
                    o[6] = v1[2] * (s * (float)((g.y >> 16) & 255u)); o[7] = v1[3] * (s * (float)(g.y >> 24));
                    u32x4 w; w.x = pk_bf16(o[0], o[1]); w.y = pk_bf16(o[2], o[3]); w.z = pk_bf16(o[4], o[5]); w.w = pk_bf16(o[6], o[7]);
                    *(u32x4*)(O + r * DM + col0 + bj * HALF) = w; } }
        }
    }
};

template <class Epi, bool SEG = false>
__device__ __forceinline__ void gemm_phase(LAS unsigned char* lds, const Gemm g, const Order& S, const Epi& E, const size_t ar1 = 0, const size_t ar2 = 0, const size_t brep = 0) {
    const int tid = opaque_tid(), wid = __builtin_amdgcn_readfirstlane(tid >> 6), lane = tid & 63, wr = wid >> 2, wc = wid & 3, fr = lane & 15, fq = lane >> 4;
    const int K = g.K; (void)K;
    unsigned voffA[2], voffB[2];
#pragma unroll
    for (int i = 0; i < 2; ++i) { int R, C; stage_rc(tid * 16 + i * 8192, R, C); const int Rb = (R & ~31) + perm32(R & 31);
        voffA[i] = (unsigned)(R * g.lda + C) * 2u; voffB[i] = (unsigned)(Rb * g.ldb + C) * 2u; }
    const size_t kstep = (size_t)(BK * 2);
    const size_t hstepA = (size_t)HALF * g.lda * 2, hstepB = (size_t)HALF * g.ldb * 2;
    const unsigned ldsw = (unsigned)wid * 1024u;
    const int aoff = lds_byte(wr * 64 + fr, fq * 8), boff = lds_byte(wc * 32 + fr, fq * 8);
#define PG8_SA(b, h) (((b) * 2 + (h)) * HTB)
#define PG8_SB(b, h) ((4 + (b) * 2 + (h)) * HTB)
#define PG8_STAGE(bufoff, gbase, voff) do { _Pragma("unroll") for (int _i = 0; _i < 2; ++_i) \
        __builtin_amdgcn_global_load_lds((const unsigned*)((const char*)(gbase) + (voff)[_i]), (LAS unsigned*)(lds + (bufoff) + ldsw + _i * 8192), 16, 0, 0); } while (0)
#define PG8_LDA(dst, b, h) do { _Pragma("unroll") for (int m = 0; m < 4; ++m) _Pragma("unroll") for (int k = 0; k < 2; ++k) dst[m][k] = *(const LAS bf16x8*)(lds + PG8_SA(b, h) + aoff + m * 2048 + k * 1024); } while (0)
#define PG8_LDB(dst, b, h) do { _Pragma("unroll") for (int n = 0; n < 2; ++n) _Pragma("unroll") for (int k = 0; k < 2; ++k) dst[n][k] = *(const LAS bf16x8*)(lds + PG8_SB(b, h) + boff + n * 2048 + k * 1024); } while (0)
#define PG8_MMA(ai, bj, At, Bt) do { __builtin_amdgcn_s_setprio(1); _Pragma("unroll") for (int m = 0; m < 4; ++m) _Pragma("unroll") for (int n = 0; n < 2; ++n) _Pragma("unroll") for (int k = 0; k < 2; ++k) \
        acc[ai][bj][m][n] = __builtin_amdgcn_mfma_f32_16x16x32_bf16(Bt[n][k], At[m][k], acc[ai][bj][m][n], 0, 0, 0); __builtin_amdgcn_s_setprio(0); } while (0)
#define PG8_WAIT_V(n) asm volatile("s_waitcnt vmcnt(" #n ")" ::: "memory")
#define PG8_WAIT_L(n) asm volatile("s_waitcnt lgkmcnt(" #n ")" ::: "memory")
#define PG8_BAR __builtin_amdgcn_s_barrier()
#define PG8_SCHED __builtin_amdgcn_sched_barrier(0)
    Unit cur, nxt; int ui = 0;
    if (!S.next(0, cur)) return;
    f32x4 acc[2][2][4][2];
#pragma unroll
    for (int a = 0; a < 2; ++a)
#pragma unroll
        for (int b = 0; b < 2; ++b)
#pragma unroll
            for (int m = 0; m < 4; ++m)
#pragma unroll
                for (int n = 0; n < 2; ++n) acc[a][b][m][n] = (f32x4){0.f, 0.f, 0.f, 0.f};
    bf16x8 At[4][2], B0[2][2], B1[2][2];
    const char* cA = (const char*)g.A + cur.aoff; const char* cB = (const char*)g.Bt + cur.boff;
    PG8_STAGE(PG8_SB(0, 0), cB, voffB); PG8_STAGE(PG8_SA(0, 0), cA, voffA); PG8_STAGE(PG8_SB(0, 1), cB + hstepB, voffB); PG8_STAGE(PG8_SA(0, 1), cA + hstepA, voffA);
    if (wr == 1) PG8_BAR;
    PG8_WAIT_V(4); PG8_BAR;
    PG8_STAGE(PG8_SB(1, 0), cB + kstep, voffB); PG8_STAGE(PG8_SA(1, 0), cA + kstep, voffA); PG8_STAGE(PG8_SB(1, 1), cB + hstepB + kstep, voffB);
    PG8_WAIT_V(6); PG8_BAR;
    for (;;) {
        const bool has_next = S.next(ui + 1, nxt);
        const char* nA = has_next ? (const char*)g.A + nxt.aoff : cA; const char* nB = has_next ? (const char*)g.Bt + nxt.boff : cB;
        const int nt = SEG ? 24 : cur.nt;
        for (int t = 0; t < nt; t += 2) {
            const bool last = (t == nt - 2);
            const char *a1, *a2, *b2;
            if constexpr (SEG) { const int s1 = t >> 3, s2 = (t + 2) >> 3;
                a1 = cA + (size_t)(s1 > 0 ? 1 : 0) * (ar1 + (size_t)(s1 - 1) * ar2) + (size_t)((t & 7) + 1) * kstep;
                a2 = last ? nA : cA + (size_t)(s2 > 0 ? 1 : 0) * (ar1 + (size_t)(s2 - 1) * ar2) + (size_t)((t + 2) & 7) * kstep;
                b2 = last ? nB : cB + (size_t)s2 * brep + (size_t)((t + 2) & 7) * kstep;
                if constexpr (SEG) { if (t == 8 || t == 16) E.hook(acc, cur, t >> 3, wr, wc, fr, fq); }
            } else { a1 = cA + (size_t)(t + 1) * kstep; a2 = last ? nA : cA + (size_t)(t + 2) * kstep; b2 = last ? nB : cB + (size_t)(t + 2) * kstep; }
            const char* a3 = a2 + kstep; const char* b3 = b2 + kstep;
            PG8_LDB(B0, 0, 0); PG8_SCHED; PG8_LDA(At, 0, 0); PG8_STAGE(PG8_SA(1, 1), a1 + hstepA, voffA);
            PG8_WAIT_L(8); PG8_BAR; PG8_WAIT_L(0); PG8_MMA(0, 0, At, B0); PG8_BAR; PG8_SCHED;
            PG8_LDB(B1, 0, 1); PG8_STAGE(PG8_SB(0, 0), b2, voffB);
            PG8_BAR; PG8_WAIT_L(0); PG8_MMA(0, 1, At, B1); PG8_BAR;
            PG8_LDA(At, 0, 1); PG8_STAGE(PG8_SA(0, 0), a2, voffA);
            PG8_BAR; PG8_WAIT_L(0); PG8_MMA(1, 0, At, B0); PG8_BAR; PG8_SCHED;
            PG8_STAGE(PG8_SB(0, 1), b2 + hstepB, voffB);
            PG8_WAIT_V(6); PG8_BAR; PG8_MMA(1, 1, At, B1); PG8_BAR;
            PG8_LDB(B0, 1, 0); PG8_SCHED; PG8_LDA(At, 1, 0); PG8_STAGE(PG8_SA(0, 1), a2 + hstepA, voffA);
            PG8_WAIT_L(8); PG8_BAR; PG8_WAIT_L(0); PG8_MMA(0, 0, At, B0); PG8_BAR; PG8_SCHED;
            PG8_LDB(B1, 1, 1); PG8_STAGE(PG8_SB(1, 0), b3, voffB);
            PG8_BAR; PG8_WAIT_L(0); PG8_MMA(0, 1, At, B1); PG8_BAR;
            PG8_LDA(At, 1, 1); PG8_STAGE(PG8_SA(1, 0), a3, voffA);
            PG8_BAR; PG8_WAIT_L(0); PG8_MMA(1, 0, At, B0); PG8_BAR; PG8_SCHED;
            PG8_STAGE(PG8_SB(1, 1), b3 + hstepB, voffB);
            PG8_WAIT_V(6); PG8_BAR; PG8_MMA(1, 1, At, B1); PG8_BAR;
        }
        E(acc, cur, wr, wc, fr, fq);
        if (!has_next) break;
#pragma unroll
        for (int a = 0; a < 2; ++a)
#pragma unroll
            for (int b = 0; b < 2; ++b)
#pragma unroll
                for (int m = 0; m < 4; ++m)
#pragma unroll
                    for (int n = 0; n < 2; ++n) acc[a][b][m][n] = (f32x4){0.f, 0.f, 0.f, 0.f};
        cur = nxt; cA = nA; cB = nB; ++ui;
    }
    PG8_WAIT_V(0);
    if (wr == 0) PG8_BAR;
    PG8_BAR;
#undef PG8_SA
#undef PG8_SB
#undef PG8_STAGE
#undef PG8_LDA
#undef PG8_LDB
#undef PG8_MMA
#undef PG8_WAIT_V
#undef PG8_WAIT_L
#undef PG8_BAR
#undef PG8_SCHED
}
}

__device__ __forceinline__ void conv_tile(float* lf, const float* __restrict__ src, int ld, bf16_t* dst, int K, int tv, int tk4, int map) {
    const int tid = opaque_tid();
    { const int vq = tid & 15, kr = tid >> 4; const int v = tv * 64 + vq * 4;
      int sc = v;
      if (map == 1) sc = (((v >> 7) & 1) ? DFF : 0) + (v >> 8) * 128 + (v & 127);
      else if (map == 2 && v < QKVC) {
          const int tl = v >> 8, vv = v & 255, bj = vv >> 7, o = vv & 127, wcv = o >> 5, ii = o & 31;
          if (tl == 2 || tl == 3 || tl == 7) sc = tl * 256 + wcv * 64 + bj * 32 + ii;
          else if (tl == 14) sc = wcv < 2 ? 3584 + wcv * 64 + bj * 32 + ii : 3712 + bj * 64 + (wcv - 2) * 32 + ii; }
      else if (map == 2 && v >= QKVC) { const int vv = v - QKVC, o = vv & 127;
          sc = QKVC + (vv >> 8) * 256 + (o >> 5) * 64 + ((o >> 3) & 3) * 16 + ((vv >> 7) & 1) * 8 + (o & 7); }
      const float* sp = src + (size_t)(tk4 * 256 + kr) * ld + sc;
      f32x4 x[8];
#pragma unroll
      for (int j = 0; j < 8; ++j) x[j] = *(const f32x4*)(sp + (size_t)(j * 32) * ld);
#pragma unroll
      for (int j = 0; j < 8; ++j) { float* lp = lf + (j * 32 + kr) * 65 + vq * 4; lp[0] = x[j][0]; lp[1] = x[j][1]; lp[2] = x[j][2]; lp[3] = x[j][3]; } }
    __syncthreads();
    { const int lane = tid & 63, w = tid >> 6;
#pragma unroll
      for (int jj = 0; jj < 4; ++jj) { const int task = w + jj * 8; const int v = (task & 7) * 8 + (lane & 7), k0 = ((task >> 3) * 8 + (lane >> 3)) * 8;
          float f[8];
#pragma unroll
          for (int e = 0; e < 8; ++e) f[e] = lf[(k0 + e) * 65 + v];
          u32x4 wv; wv.x = pk_bf16(f[0], f[1]); wv.y = pk_bf16(f[2], f[3]); wv.z = pk_bf16(f[4], f[5]); wv.w = pk_bf16(f[6], f[7]);
          *(u32x4*)(dst + (size_t)(tv * 64 + v) * K + tk4 * 256 + k0) = wv; } }
    __syncthreads();
}
constexpr int CONV_FFN_TILES = 352 + 176, CONV_MIX_TILES = 432 + 96 + 64;
__device__ __forceinline__ void conv_ffn(const Params& p, float* lf, int l, int which, int it) {
    if (it < 352) conv_tile(lf, p.w_ffn_in + (size_t)(l * 2 + which) * DM * 2 * DFF, 2 * DFF, (bf16_t*)(p.ws + WS_WFI), DM, it >> 2, it & 3, 1);
    else { it -= 352; conv_tile(lf, p.w_ffn_out + (size_t)(l * 2 + which) * DFF * DM, DM, (bf16_t*)(p.ws + WS_WFO), DFF, it / 11, it % 11, 0); }
}
__device__ __forceinline__ void conv_mix(const Params& p, float* lf, int l, int it) {
    if (it < 432) conv_tile(lf, p.w_in + (size_t)l * DM * INC, INC, (bf16_t*)(p.ws + WS_WMI), DM, it >> 2, it & 3, 2);
    else if (it < 432 + 96) { const int j = it - 432, br = j >> 5, jj = j & 31;
        conv_tile(lf, p.w_branch + (size_t)(l * 3 + br) * 512 * DM, DM, (bf16_t*)(p.ws + WS_WMB) + (size_t)br * DM * 512, 512, jj >> 1, jj & 1, 0); }
    else { const int j = it - 528; conv_tile(lf, p.w_out + (size_t)l * DM * DM, DM, (bf16_t*)(p.ws + WS_WMO), DM, j >> 2, j & 3, 0); }
}

__device__ __forceinline__ void conv_tail(const Params& p, unsigned char* lds, int cw, int total, int mix, int l, int which) {
    unsigned* ctr = (unsigned*)(p.ws + WS_BAR) + 3600 + cw;
    volatile LAS unsigned* slot = (volatile LAS unsigned*)((LAS unsigned char*)lds + LDS_MAIN) + 2;
    float* lf = (float*)lds;
    for (;;) {
        if (threadIdx.x == 0) slot[0] = atomicAdd(ctr, 1u);
        __syncthreads();
        const int it = (int)slot[0];
        __syncthreads();
        if (it >= total) break;
        if (mix) conv_mix(p, lf, l, it); else conv_ffn(p, lf, l, which, it);
    }
}

__device__ __forceinline__ void mod_item(const Params& p, float* lf, int it) {
    float* sl = lf;
    float* red = lf + 1024 * 20;
    const int tid = opaque_tid(), lane = tid & 63, w = tid >> 6;
    const int l = it / 144, col0 = (it % 144) * 64;
    for (int idx = tid; idx < 17 * 1024; idx += NTHREADS) { const int r = idx >> 10, k = idx & 1023; const float v = r < 16 ? p.c[r * 1024 + k] : p.c_ctx[k]; sl[k * 20 + r] = v / (1.0f + __expf(-v)); }
    __syncthreads();
    float acc[17];
#pragma unroll
    for (int r = 0; r < 17; ++r) acc[r] = 0.f;
    const float* wp = p.w_mod + ((size_t)l * DM + w * 128) * MODC + col0 + lane;
#pragma unroll 8
    for (int k = 0; k < 128; ++k) {
        const float wv = wp[(size_t)k * MODC];
        const float* sp = sl + (w * 128 + k) * 20;
        const f32x4 s0 = *(const f32x4*)(sp), s1 = *(const f32x4*)(sp + 4), s2 = *(const f32x4*)(sp + 8), s3 = *(const f32x4*)(sp + 12); const float s4 = sp[16];
        acc[0] += s0[0] * wv; acc[1] += s0[1] * wv; acc[2] += s0[2] * wv; acc[3] += s0[3] * wv;
        acc[4] += s1[0] * wv; acc[5] += s1[1] * wv; acc[6] += s1[2] * wv; acc[7] += s1[3] * wv;
        acc[8] += s2[0] * wv; acc[9] += s2[1] * wv; acc[10] += s2[2] * wv; acc[11] += s2[3] * wv;
        acc[12] += s3[0] * wv; acc[13] += s3[1] * wv; acc[14] += s3[2] * wv; acc[15] += s3[3] * wv; acc[16] += s4 * wv;
    }
#pragma unroll
    for (int r = 0; r < 17; ++r) red[(w * 17 + r) * 64 + lane] = acc[r];
    __syncthreads();
    float* mod = (float*)(p.ws + WS_MOD);
    for (int o = tid; o < 17 * 64; o += NTHREADS) { const int r = o >> 6, ln = o & 63; float s = p.b_mod[l * MODC + col0 + ln];
#pragma unroll
        for (int ww = 0; ww < 8; ++ww) s += red[(ww * 17 + r) * 64 + ln];
        mod[((size_t)l * 17 + r) * MODC + col0 + ln] = s; }
    __syncthreads();
}
__device__ __forceinline__ void misc_item(const Params& p) {
    const int tid = opaque_tid();
    f32x2* rope = (f32x2*)(p.ws + WS_ROPE);
    for (int e = tid; e < 1024; e += NTHREADS) { const int pos = e >> 4, f = e & 15;
        const float inv = powf(10000.0f, -(float)f / 16.0f); const float ang = (float)pos * inv;
        double a = (double)ang * 0.15915494309189535; a -= floor(a); const float fr = (float)a;
        rope[e] = (f32x2){__builtin_amdgcn_cosf(fr), __builtin_amdgcn_sinf(fr)}; }
    float* misc = (float*)(p.ws + WS_MISC);
    if (tid < DEPTH) { const int l = tid; const float* dl = p.diff_lambda + l * 256; float s1 = 0.f, s2 = 0.f;
        for (int i = 0; i < 64; ++i) { s1 += dl[i] * dl[64 + i]; s2 += dl[128 + i] * dl[192 + i]; }
        const float lam_init = 0.8f - 0.6f * expf(-0.3f * (float)l);
        misc[l * 16 + 0] = expf(s1) - expf(s2) + lam_init; misc[l * 16 + 1] = lam_init; }
    if (tid >= 64 && tid < 64 + DEPTH * 8) { const int j = tid - 64, l = j >> 3, dh = j & 7;
        const float x = p.ret_logit[l * 8 + dh]; misc[l * 16 + 4 + dh] = -log1pf(expf(-x)) * 1.4426950408889634f; }
}

struct ERow { f32x4 h[4]; u32x2 y[4]; };
__device__ __forceinline__ void erow_load(ERow& r, const Params& p, bool first, bool from_input, const bf16_t* ysrc, bool ysplit, int t, int lane) {
    const int b = t / TPB, n = t - b * TPB; const bool isctx = n >= SEQ;
    const float* hsrc = from_input ? (isctx ? p.ctx + (size_t)(b * CTXL + n - SEQ) * DM : p.x + (size_t)(b * SEQ + n) * DM)
                              : (isctx ? (const float*)(p.ws + WS_HC) + (size_t)(b * CTXL + n - SEQ) * DM : p.out + (size_t)(b * SEQ + n) * DM);
#pragma unroll
    for (int i = 0; i < 4; ++i) r.h[i] = __builtin_nontemporal_load((const f32x4*)(hsrc + i * 256 + lane * 4));
    if (!first) {
        const bf16_t* yp = (ysplit && isctx) ? (const bf16_t*)(p.ws + WS_PART) + (size_t)(b * CTXL + n - SEQ) * DM : ysrc + (size_t)t * DM;
#pragma unroll
        for (int i = 0; i < 4; ++i) r.y[i] = *(const u32x2*)(yp + i * 256 + lane * 4);
    }
}
__device__ __forceinline__ void ephase_rows(const Params& p, bool first, bool from_input, int lp, int sp, float gs, const bf16_t* ysrc, bool ysplit, int ln, int sn, bool latent_only, int dummy) {
    const int tid = opaque_tid(); const int lane = tid & 63, w = tid >> 6;
    const float* mod = (const float*)(p.ws + WS_MOD);
    float* hc = (float*)(p.ws + WS_HC);
    bf16_t* Y = (bf16_t*)(p.ws + WS_Y);
    const int nrows = latent_only ? NB * SEQ : NT, stride = gridDim.x * 8;
    int i = blockIdx.x * 8 + w;
    if (i >= nrows) return;
    ERow cur, nxt;
    int t = latent_only ? (i >> 11) * TPB + (i & 2047) : i;
    erow_load(cur, p, first, from_input, ysrc, ysplit, t, lane);
    for (;;) {
        const int in = i + stride; const bool has_next = in < nrows;
        const int tn = latent_only ? (in >> 11) * TPB + (in & 2047) : in;
        if (has_next) erow_load(nxt, p, first, from_input, ysrc, ysplit, tn, lane);
        const int b = t / TPB, n = t - b * TPB; const bool isctx = n >= SEQ;
        float* hp = isctx ? hc + (size_t)(b * CTXL + n - SEQ) * DM : p.out + (size_t)(b * SEQ + n) * DM;
        const int mrow = isctx ? 16 : b;
        f32x4 h[4];
#pragma unroll
        for (int k = 0; k < 4; ++k) h[k] = cur.h[k];
        if (!first) {
            const float* mp = mod + ((size_t)lp * 17 + mrow) * MODC + sp * 3072 + 2048;
            const float* gpost = p.norm_g + (size_t)(lp * 6 + 2 * sp + 1) * DM;
            f32x4 y[4]; float ss = 0.f;
#pragma unroll
            for (int k = 0; k < 4; ++k) { const u32x2 v = cur.y[k]; y[k] = (f32x4){bf_lo(v.x), bf_hi(v.x), bf_lo(v.y), bf_hi(v.y)}; }
            if (ysplit && isctx) {
                const bf16_t* pp = (const bf16_t*)(p.ws + WS_PART) + (size_t)(b * CTXL + n - SEQ) * DM + lane * 4;
#pragma unroll
                for (int q = 1; q < 4; ++q)
#pragma unroll
                    for (int k = 0; k < 4; ++k) { const u32x2 v = *(const u32x2*)(pp + (size_t)q * (NB * CTXL) * DM + k * 256); y[k] += (f32x4){bf_lo(v.x), bf_hi(v.x), bf_lo(v.y), bf_hi(v.y)}; }
            }
#pragma unroll
            for (int k = 0; k < 4; ++k) ss += y[k][0] * y[k][0] + y[k][1] * y[k][1] + y[k][2] * y[k][2] + y[k][3] * y[k][3];
            ss = wave_sum(ss); const float r = rsqrtf(ss * (1.0f / DM) + EPS);
#pragma unroll
            for (int k = 0; k < 4; ++k) { const f32x4 ga = *(const f32x4*)(mp + k * 256 + lane * 4), gp = *(const f32x4*)(gpost + k * 256 + lane * 4);
                h[k] += gs * ga * (y[k] * r * gp); }
        }
#pragma unroll
        for (int k = 0; k < 4; ++k) if (!dummy && !first) __builtin_nontemporal_store(h[k], (f32x4*)(hp + k * 256 + lane * 4));
        if (sn >= 0) {
            float ss = 0.f;
#pragma unroll
            for (int k = 0; k < 4; ++k) ss += h[k][0] * h[k][0] + h[k][1] * h[k][1] + h[k][2] * h[k][2] + h[k][3] * h[k][3];
            ss = wave_sum(ss); const float r = rsqrtf(ss * (1.0f / DM) + EPS);
            const float* mp = mod + ((size_t)ln * 17 + mrow) * MODC + sn * 3072;
            const float* gpre = p.norm_g + (size_t)(ln * 6 + 2 * sn) * DM;
#pragma unroll
            for (int k = 0; k < 4; ++k) { const f32x4 sh = *(const f32x4*)(mp + k * 256 + lane * 4), sc = *(const f32x4*)(mp + 1024 + k * 256 + lane * 4), gp = *(const f32x4*)(gpre + k * 256 + lane * 4);
                const f32x4 o = h[k] * r * gp * (1.0f + sc) + sh;
                u32x2 wv; wv.x = pk_bf16(o[0], o[1]); wv.y = pk_bf16(o[2], o[3]);
                if (!dummy) *(u32x2*)(Y + (size_t)t * DM + k * 256 + lane * 4) = wv; }
        }
        if (!has_next) break;
        cur = nxt; i = in; t = tn;
    }
}

__device__ __forceinline__ void rope_phase(const Params& p, int l, int dummy) {
    bf16_t* P = (bf16_t*)(p.ws + WS_P);
    const f32x2* rope = (const f32x2*)(p.ws + WS_ROPE);
    const long total = (long)NT * 56;
    const int tid = opaque_tid();
    for (long idx = (long)blockIdx.x * NTHREADS + tid; idx < total; idx += (long)gridDim.x * NTHREADS) {
        const int t = (int)(idx / 56), rem = (int)(idx - (long)t * 56), gi = rem >> 2, j = rem & 3;
        const int n = t % TPB; const bool isctx = n >= SEQ;
        const bool cnorm = gi >= 12;
        if (isctx && !cnorm) continue;
        const int col = gi < 8 ? 512 + gi * 64 : (gi < 12 ? 1792 + (gi - 8) * 64 : 3584 + (gi - 12) * 64);
        bf16_t* bp = P + (size_t)t * QKVC + col + j * 8;
        const u32x4 r1 = *(const u32x4*)bp, r2 = *(const u32x4*)(bp + 32);
        float x1[8] = {bf_lo(r1.x), bf_hi(r1.x), bf_lo(r1.y), bf_hi(r1.y), bf_lo(r1.z), bf_hi(r1.z), bf_lo(r1.w), bf_hi(r1.w)};
        float x2[8] = {bf_lo(r2.x), bf_hi(r2.x), bf_lo(r2.y), bf_hi(r2.y), bf_lo(r2.z), bf_hi(r2.z), bf_lo(r2.w), bf_hi(r2.w)};
        if (cnorm) {
            float ss = 0.f;
#pragma unroll
            for (int e = 0; e < 8; ++e) ss += x1[e] * x1[e] + x2[e] * x2[e];
            ss += __shfl_xor(ss, 1); ss += __shfl_xor(ss, 2);
            const float r = rsqrtf(ss * (1.0f / 64.0f) + EPS);
            const float* g = p.qk_norm_g + (size_t)(l * 2 + 1) * 64 + j * 8;
#pragma unroll
            for (int e = 0; e < 8; ++e) { x1[e] *= r * g[e]; x2[e] *= r * g[32 + e]; }
        }
        if (!isctx) {
            const int pos = (j < 2) ? (n >> 6) : (n & 63);
            const f32x2* cs = rope + pos * 16 + (j & 1) * 8;
#pragma unroll
            for (int e = 0; e < 8; ++e) { const f32x2 v = cs[e]; const float a = x1[e], bq = x2[e]; x1[e] = a * v.x - bq * v.y; x2[e] = a * v.y + bq * v.x; }
        }
        if (!dummy) {
            u32x4 w1, w2;
            w1.x = pk_bf16(x1[0], x1[1]); w1.y = pk_bf16(x1[2], x1[3]); w1.z = pk_bf16(x1[4], x1[5]); w1.w = pk_bf16(x1[6], x1[7]);
            w2.x = pk_bf16(x2[0], x2[1]); w2.y = pk_bf16(x2[2], x2[3]); w2.z = pk_bf16(x2[4], x2[5]); w2.w = pk_bf16(x2[6], x2[7]);
            *(u32x4*)bp = w1; *(u32x4*)(bp + 32) = w2;
        }
    }
}

__device__ __forceinline__ void rs1_task(const Params& p, unsigned char* lds, int l, int task) {
    constexpr int KST = 160, VST = 288, KB = 64 * KST, VB = 64 * VST;
    const int tid = opaque_tid(), lane = tid & 63, w = __builtin_amdgcn_readfirstlane(tid >> 6), lq = lane & 15, g = lane >> 4;
    const int blk = task % 9, bh = task / 9, h = bh & 3, b = bh >> 2;
    const bf16_t* P = (const bf16_t*)(p.ws + WS_P);
    const float* misc = (const float*)(p.ws + WS_MISC) + l * 16;
    const float lf2 = misc[4 + h], lb2 = misc[8 + h];
    const size_t row0 = (size_t)b * TPB + (blk < 8 ? blk * 256 : SEQ);
    const int kcol = 1792 + h * 64, vcol = 2048 + h * 128;
    const unsigned lds_base = (unsigned)(uintptr_t)(LAS unsigned char*)lds;
    const unsigned kaddr = lds_base + (4 * g + (lq >> 2)) * KST + (lq & 3) * 8;
    const unsigned vaddr = lds_base + KB + (4 * g + (lq >> 2)) * VST + (lq & 3) * 8 + w * 32;
    f32x4 Uf[4], Ub[4];
#pragma unroll
    for (int i = 0; i < 4; ++i) { Uf[i] = (f32x4){0.f, 0.f, 0.f, 0.f}; Ub[i] = (f32x4){0.f, 0.f, 0.f, 0.f}; }
    for (int tt = 0; tt < 4; ++tt) {
        { const size_t r0 = row0 + (size_t)tt * 64;
          const int kr = tid >> 3, kc = tid & 7;
          const u32x4 kv = *(const u32x4*)(P + (r0 + kr) * QKVC + kcol + kc * 8);
          u32x4 vv[2];
#pragma unroll
          for (int i = 0; i < 2; ++i) { const int id = tid + i * NTHREADS; vv[i] = *(const u32x4*)(P + (r0 + (id >> 4)) * QKVC + vcol + (id & 15) * 8); }
          *(u32x4*)(lds + kr * KST + kc * 16) = kv;
#pragma unroll
          for (int i = 0; i < 2; ++i) { const int id = tid + i * NTHREADS; *(u32x4*)(lds + KB + (id >> 4) * VST + (id & 15) * 16) = vv[i]; } }
        __syncthreads();
#pragma unroll
        for (int st = 0; st < 2; ++st) {
            s16x4 v0, v1;
            asm volatile("ds_read_b64_tr_b16 %0, %2 offset:%3\n\tds_read_b64_tr_b16 %1, %2 offset:%4\n\ts_waitcnt lgkmcnt(0)" : "=&v"(v0), "=&v"(v1) : "v"(vaddr), "i"(st * 32 * VST), "i"(st * 32 * VST + 16 * VST) : "memory");
            const u32x2 a0 = __builtin_bit_cast(u32x2, v0), a1 = __builtin_bit_cast(u32x2, v1);
            float x[8] = {bf_lo(a0.x), bf_hi(a0.x), bf_lo(a0.y), bf_hi(a0.y), bf_lo(a1.x), bf_hi(a1.x), bf_lo(a1.y), bf_hi(a1.y)};
            float xf[8], xb[8];
#pragma unroll
            for (int e = 0; e < 8; ++e) { const int jj = tt * 64 + st * 32 + (e < 4 ? 4 * g + e : 16 + 4 * g + (e - 4));
                xf[e] = x[e] * __builtin_amdgcn_exp2f(lf2 * (float)(255 - jj)); xb[e] = x[e] * __builtin_amdgcn_exp2f(lb2 * (float)jj); }
            u32x4 pf_, pb_;
            pf_.x = pk_bf16(xf[0], xf[1]); pf_.y = pk_bf16(xf[2], xf[3]); pf_.z = pk_bf16(xf[4], xf[5]); pf_.w = pk_bf16(xf[6], xf[7]);
            pb_.x = pk_bf16(xb[0], xb[1]); pb_.y = pk_bf16(xb[2], xb[3]); pb_.z = pk_bf16(xb[4], xb[5]); pb_.w = pk_bf16(xb[6], xb[7]);
            const bf16x8 vf = __builtin_bit_cast(bf16x8, pf_), vb = __builtin_bit_cast(bf16x8, pb_);
#pragma unroll
            for (int dk = 0; dk < 4; ++dk) {
                s16x4 k0, k1;
                asm volatile("ds_read_b64_tr_b16 %0, %2 offset:%3\n\tds_read_b64_tr_b16 %1, %2 offset:%4\n\ts_waitcnt lgkmcnt(0)" : "=&v"(k0), "=&v"(k1) : "v"(kaddr), "i"(st * 32 * KST + dk * 32), "i"(st * 32 * KST + 16 * KST + dk * 32) : "memory");
                const bf16x8 kf = __builtin_shufflevector(k0, k1, 0, 1, 2, 3, 4, 5, 6, 7);
                Uf[dk] = __builtin_amdgcn_mfma_f32_16x16x32_bf16(vf, kf, Uf[dk], 0, 0, 0);
                Ub[dk] = __builtin_amdgcn_mfma_f32_16x16x32_bf16(vb, kf, Ub[dk], 0, 0, 0);
            }
        }
        __syncthreads();
    }
    float* U = (float*)(p.ws + WS_RSU) + ((size_t)(bh * 9 + blk) * 2) * 8192;
#pragma unroll
    for (int dk = 0; dk < 4; ++dk)
#pragma unroll
        for (int r = 0; r < 4; ++r) { const int o = (16 * w + 4 * g + r) * 64 + 16 * dk + lq; U[o] = Uf[dk][r]; U[8192 + o] = Ub[dk][r]; }
}
__device__ __forceinline__ void rs1_phase(const Params& p, unsigned char* lds, int l) {
    const int G = (int)gridDim.x, bx = (int)blockIdx.x;
    const int vcu = (G % 8 == 0) ? (bx % 8) * (G / 8) + bx / 8 : bx;
    for (int task = vcu; task < NB * 4 * 9; task += G) rs1_task(p, lds, l, task);
}
__device__ __forceinline__ void rs2_phase(const Params& p, int l) {
    const int tid = opaque_tid();
    const float* misc = (const float*)(p.ws + WS_MISC) + l * 16;
    for (int task = blockIdx.x; task < NB * 4 * 2; task += gridDim.x) {
        const int dir = task & 1, bh = task >> 1, h = bh & 3;
        const float g256 = __builtin_amdgcn_exp2f(256.0f * misc[4 + dir * 4 + h]);
        const float* U = (const float*)(p.ws + WS_RSU) + (size_t)bh * 9 * 2 * 8192 + dir * 8192;
        bf16_t* ST = (bf16_t*)(p.ws + WS_RST) + (size_t)bh * 8 * 2 * 8192 + dir * 8192;
        f32x4 s[4];
#pragma unroll
        for (int j = 0; j < 4; ++j) s[j] = *(const f32x4*)(U + (size_t)8 * 16384 + (tid + j * NTHREADS) * 4);
        for (int step = 0; step < 8; ++step) {
            const int i = dir ? 7 - step : step;
#pragma unroll
            for (int j = 0; j < 4; ++j) { u32x2 wv; wv.x = pk_bf16(s[j][0], s[j][1]); wv.y = pk_bf16(s[j][2], s[j][3]); *(u32x2*)(ST + (size_t)i * 16384 + (tid + j * NTHREADS) * 4) = wv;
                const f32x4 u = *(const f32x4*)(U + (size_t)i * 16384 + (tid + j * NTHREADS) * 4); s[j] = s[j] * g256 + u; }
        }
    }
}

template <int KIND>
__device__ __forceinline__ void attn_item(unsigned char* lds, bf16_t* P, const Params& p, int l, int b, int head, int qb, int isctx, int dummy) {
    constexpr int KW = (KIND == 0) ? 128 : 64, DV = (KIND == 2) ? 64 : 128, NDB = DV / 16;
    constexpr int KSTR = KW * 2, VSTR = DV * 2 + 32, KBYTES = 64 * KSTR, VBYTES = 64 * VSTR;
#define ATT_KSW(row) ((KW == 64) ? (((row) >> 1) & 7) : ((row) & 15))
    constexpr int KCH = KW / 64, VCH = DV / 64;
    const int tid = opaque_tid(), lane = tid & 63, w = tid >> 6, lq = lane & 15, g = lane >> 4;
    const float* misc = (const float*)(p.ws + WS_MISC) + l * 16;
    const int comp = (KIND == 0) ? (w >> 2) : 0;
    const int qn0 = (KIND == 0) ? qb * 128 + (w & 3) * 32 : qb * 256 + w * 32;
    const size_t rowbase = (size_t)b * TPB + (isctx ? SEQ : 0);
    const int qcol = (KIND == 0) ? head * 128 + comp * 64 : (KIND == 1) ? 1536 + head * 64 : 3072 + head * 64;
    const int kcol = (KIND == 0) ? 512 + head * 128 : (KIND == 1) ? 1792 + head * 64 : 3584 + (head >> 2) * 64;
    const int vcol = (KIND == 0) ? 1024 + head * 128 : (KIND == 1) ? 2048 + head * 128 : 3712 + (head >> 2) * 64;
    const int kt0 = isctx ? 32 : (KIND == 1 ? 4 * qb : 0), nkt = (isctx || KIND == 1) ? 4 : 36;
    const size_t keyrow0 = (size_t)b * TPB + (size_t)kt0 * 64;

    bf16x8 qf[2][2];
#pragma unroll
    for (int qs = 0; qs < 2; ++qs)
#pragma unroll
        for (int ks = 0; ks < 2; ++ks) qf[qs][ks] = *(const bf16x8*)(P + (rowbase + qn0 + qs * 16 + lq) * QKVC + qcol + ks * 32 + g * 8);
    {
        const f32x2* rope = (const f32x2*)(p.ws + WS_ROPE);
        const float qscale = (KIND == 1) ? 0.125f : 0.125f * 1.4426950408889634f;
#pragma unroll
        for (int qs = 0; qs < 2; ++qs) {
            const u32x4 r1 = __builtin_bit_cast(u32x4, qf[qs][0]), r2 = __builtin_bit_cast(u32x4, qf[qs][1]);
            float x1[8] = {bf_lo(r1.x), bf_hi(r1.x), bf_lo(r1.y), bf_hi(r1.y), bf_lo(r1.z), bf_hi(r1.z), bf_lo(r1.w), bf_hi(r1.w)};
            float x2[8] = {bf_lo(r2.x), bf_hi(r2.x), bf_lo(r2.y), bf_hi(r2.y), bf_lo(r2.z), bf_hi(r2.z), bf_lo(r2.w), bf_hi(r2.w)};
            if (KIND == 2) {
                float ss = 0.f;
#pragma unroll
                for (int e = 0; e < 8; ++e) ss += x1[e] * x1[e] + x2[e] * x2[e];
                ss += __shfl_xor(ss, 16); ss += __shfl_xor(ss, 32);
                const float rn = rsqrtf(ss * (1.0f / 64.0f) + EPS);
                const float* gq = p.qk_norm_g + (size_t)(l * 2) * 64 + g * 8;
#pragma unroll
                for (int e = 0; e < 8; ++e) { x1[e] *= rn * gq[e]; x2[e] *= rn * gq[32 + e]; }
            }
            if (!isctx) {
                const int n = qn0 + qs * 16 + lq;
                const int pos = (g < 2) ? (n >> 6) : (n & 63);
                const f32x2* cs = rope + pos * 16 + (g & 1) * 8;
#pragma unroll
                for (int e = 0; e < 8; ++e) { const f32x2 v = cs[e]; const float a = x1[e], bq = x2[e]; x1[e] = a * v.x - bq * v.y; x2[e] = a * v.y + bq * v.x; }
            }
#pragma unroll
            for (int e = 0; e < 8; ++e) { x1[e] *= qscale; x2[e] *= qscale; }
            u32x4 w1, w2;
            w1.x = pk_bf16(x1[0], x1[1]); w1.y = pk_bf16(x1[2], x1[3]); w1.z = pk_bf16(x1[4], x1[5]); w1.w = pk_bf16(x1[6], x1[7]);
            w2.x = pk_bf16(x2[0], x2[1]); w2.y = pk_bf16(x2[2], x2[3]); w2.z = pk_bf16(x2[4], x2[5]); w2.w = pk_bf16(x2[6], x2[7]);
            qf[qs][0] = __builtin_bit_cast(bf16x8, w1); qf[qs][1] = __builtin_bit_cast(bf16x8, w2);
        }
    }

    float lf2 = 0.f, lb2 = 0.f;
    if (KIND == 1) { lf2 = misc[4 + head]; lb2 = misc[8 + head]; }

    f32x4 O[NDB][2];
    float mrun[2];
    f32x4 Ol[2];
    const bf16x8 ones = (bf16x8){16256, 16256, 16256, 16256, 16256, 16256, 16256, 16256};

    u32x4 kreg[2][KCH], vreg[2][VCH];
    int krow[KCH], kcc[KCH], vrow[VCH], vcc[VCH];
#pragma unroll
    for (int i = 0; i < KCH; ++i) { const int id = tid + i * NTHREADS; krow[i] = id / (KW / 8); kcc[i] = id % (KW / 8); }
#pragma unroll
    for (int i = 0; i < VCH; ++i) { const int id = tid + i * NTHREADS; vrow[i] = id / (DV / 8); vcc[i] = id % (DV / 8); }
#define ATT_LOAD(t, set) do { const size_t r0 = keyrow0 + (size_t)(t) * 64; \
        _Pragma("unroll") for (int i = 0; i < KCH; ++i) kreg[set][i] = *(const u32x4*)(P + (r0 + krow[i]) * QKVC + kcol + kcc[i] * 8); \
        _Pragma("unroll") for (int i = 0; i < VCH; ++i) vreg[set][i] = *(const u32x4*)(P + (r0 + vrow[i]) * QKVC + vcol + vcc[i] * 8); } while (0)
#define ATT_STORE(buf, vbuf, set) do { unsigned char* kb_ = lds + (buf) * KBYTES; unsigned char* vb_ = lds + 2 * KBYTES + (vbuf) * VBYTES; \
        _Pragma("unroll") for (int i = 0; i < KCH; ++i) *(u32x4*)(kb_ + krow[i] * KSTR + ((kcc[i] ^ ATT_KSW(krow[i])) * 16)) = kreg[set][i]; \
        _Pragma("unroll") for (int i = 0; i < VCH; ++i) *(u32x4*)(vb_ + vrow[i] * VSTR + vcc[i] * 16) = vreg[set][i]; } while (0)

    const unsigned lds_base = (unsigned)(uintptr_t)(LAS unsigned char*)lds;
    const float csc = 0.125f * 1.4426950408889634f;
    float dfa0 = 0.f, dba0 = 0.f, f16 = 0.f, b16 = 0.f, dfr[4] = {1.f, 1.f, 1.f, 1.f}, dbr[4] = {1.f, 1.f, 1.f, 1.f};
    if (KIND == 1) {
        dfa0 = __builtin_amdgcn_exp2f(-lf2 * (float)(4 * g)); dba0 = __builtin_amdgcn_exp2f(lb2 * (float)(4 * g));
        f16 = __builtin_amdgcn_exp2f(-lf2 * 16.0f); b16 = __builtin_amdgcn_exp2f(lb2 * 16.0f);
#pragma unroll
        for (int i = 1; i < 4; ++i) { dfr[i] = __builtin_amdgcn_exp2f(-lf2 * (float)i); dbr[i] = __builtin_amdgcn_exp2f(lb2 * (float)i); }
    }
#define ATT_TR(dst, db) asm volatile("ds_read_b64_tr_b16 %0, %4 offset:%5\n\tds_read_b64_tr_b16 %1, %4 offset:%6\n\tds_read_b64_tr_b16 %2, %4 offset:%7\n\tds_read_b64_tr_b16 %3, %4 offset:%8" \
                         : "=&v"(dst[0]), "=&v"(dst[1]), "=&v"(dst[2]), "=&v"(dst[3]) \
                         : "v"(vaddr), "i"((db) * 32), "i"((db) * 32 + 16 * VSTR), "i"((db) * 32 + 32 * VSTR), "i"((db) * 32 + 48 * VSTR) : "memory")
#define ATT_PV(vb) do { const unsigned vaddr = vaddr0 + (unsigned)(vb) * VBYTES; s16x4 vr[2][4]; ATT_TR(vr[0], 0); \
        _Pragma("unroll") for (int db = 0; db < NDB; ++db) { \
            if (db + 1 < NDB) { ATT_TR(vr[(db + 1) & 1], db + 1); \
                asm volatile("s_waitcnt lgkmcnt(4)" : "+v"(vr[db & 1][0]), "+v"(vr[db & 1][1]), "+v"(vr[db & 1][2]), "+v"(vr[db & 1][3]) :: "memory"); } \
            else asm volatile("s_waitcnt lgkmcnt(0)" : "+v"(vr[db & 1][0]), "+v"(vr[db & 1][1]), "+v"(vr[db & 1][2]), "+v"(vr[db & 1][3]) :: "memory"); \
            const bf16x8 vf0 = __builtin_shufflevector(vr[db & 1][0], vr[db & 1][1], 0, 1, 2, 3, 4, 5, 6, 7); \
            const bf16x8 vf1 = __builtin_shufflevector(vr[db & 1][2], vr[db & 1][3], 0, 1, 2, 3, 4, 5, 6, 7); \
            __builtin_amdgcn_s_setprio(1); \
            _Pragma("unroll") for (int qs = 0; qs < 2; ++qs) { \
                O[db][qs] = __builtin_amdgcn_mfma_f32_16x16x32_bf16(vf0, pf[qs][0], O[db][qs], 0, 0, 0); \
                O[db][qs] = __builtin_amdgcn_mfma_f32_16x16x32_bf16(vf1, pf[qs][1], O[db][qs], 0, 0, 0); } \
            __builtin_amdgcn_s_setprio(0); } } while (0)
    const bool skew = ATT_SKEW && (w >= 4);
    const unsigned vaddr0 = lds_base + 2 * KBYTES + (4 * g + (lq >> 2)) * VSTR + (lq & 3) * 8;
    bf16x8 pf[2][2];
    volatile LAS unsigned* oflag = (volatile LAS unsigned*)((LAS unsigned char*)lds + LDS_MAIN) + 3;
    int safe = (KIND == 1 || ATT_FORCE == 1) ? 1 : 0;
    for (;;) {
#pragma unroll
    for (int db = 0; db < NDB; ++db) { O[db][0] = (f32x4){0.f, 0.f, 0.f, 0.f}; O[db][1] = (f32x4){0.f, 0.f, 0.f, 0.f}; }
#pragma unroll
    for (int qs = 0; qs < 2; ++qs) { mrun[qs] = 0.f; Ol[qs] = (f32x4){0.f, 0.f, 0.f, 0.f}; pf[qs][0] = (bf16x8){0, 0, 0, 0, 0, 0, 0, 0}; pf[qs][1] = (bf16x8){0, 0, 0, 0, 0, 0, 0, 0}; }
    if (KIND != 1 && tid == 0) oflag[0] = 0u;
    ATT_LOAD(0, 0); ATT_STORE(0, 0, 0);
    ATT_LOAD(1, 1);
    int vcur = 0, vprev = 2;
    for (int t2 = 0; t2 < nkt; t2 += 2) {
#pragma unroll
      for (int u = 0; u < 2; ++u) {
        const int t = t2 + u;
        const int buf = u;
        const int vnext = (vcur == 2) ? 0 : vcur + 1;
        __syncthreads();
        if (t + 1 < nkt) ATT_STORE(buf ^ 1, vnext, 1 - u);
        if (t + 2 < nkt) ATT_LOAD(t + 2, u);
        const unsigned char* Kb = lds + buf * KBYTES;
        if (skew && t > 0) ATT_PV(vprev);
        f32x4 s[4][2];
        __builtin_amdgcn_s_setprio(2);
#pragma unroll
        for (int kb = 0; kb < 4; ++kb) {
            const bf16x8 kf0 = *(const bf16x8*)(Kb + (kb * 16 + lq) * KSTR + (((comp * 8 + g) ^ ATT_KSW(lq)) * 16));
            const bf16x8 kf1 = *(const bf16x8*)(Kb + (kb * 16 + lq) * KSTR + (((comp * 8 + 4 + g) ^ ATT_KSW(lq)) * 16));
            if (KIND != 1 && safe) {
#pragma unroll
                for (int qs = 0; qs < 2; ++qs) {
                    f32x4 a = (f32x4){-mrun[qs], -mrun[qs], -mrun[qs], -mrun[qs]};
                    a = __builtin_amdgcn_mfma_f32_16x16x32_bf16(kf0, qf[qs][0], a, 0, 0, 0);
                    a = __builtin_amdgcn_mfma_f32_16x16x32_bf16(kf1, qf[qs][1], a, 0, 0, 0);
                    s[kb][qs] = a;
                }
            } else {
#pragma unroll
                for (int qs = 0; qs < 2; ++qs) {
                    f32x4 a = (f32x4){0.f, 0.f, 0.f, 0.f};
                    a = __builtin_amdgcn_mfma_f32_16x16x32_bf16(kf0, qf[qs][0], a, 0, 0, 0);
                    a = __builtin_amdgcn_mfma_f32_16x16x32_bf16(kf1, qf[qs][1], a, 0, 0, 0);
                    s[kb][qs] = a;
                }
            }
        }
        __builtin_amdgcn_s_setprio(0);
        if (KIND == 1) {
            const int kk0 = (kt0 + t) * 64;
            const int PF0 = kk0 < SEQ ? kk0 + CTXL : kk0 - SEQ;
            const int pfq_min = isctx ? qn0 : qn0 + CTXL, pbq_min = isctx ? SEQ + qn0 : qn0;
            const bool f_full = (pfq_min - PF0 - 63 >= 0), f_none = (pfq_min + 31 - PF0 < 0);
            const bool b_full = (kk0 - (pbq_min + 31) >= 0), b_none = (kk0 + 63 - pbq_min < 0);
            const bool clean = (f_full || f_none) && (b_full || b_none);
#pragma unroll
            for (int qs = 0; qs < 2; ++qs) {
                const int qpf = pfq_min + qs * 16 + lq, qpb = pbq_min + qs * 16 + lq;
                const int tf = qpf - PF0 - 4 * g, tb = qpb - kk0 - 4 * g;
                float cfk = f_none ? 0.f : __builtin_amdgcn_exp2f(lf2 * (float)(qpf - PF0)) * dfa0;
                float cbk = b_none ? 0.f : __builtin_amdgcn_exp2f(lb2 * (float)(kk0 - qpb)) * dba0;
                if (clean) {
#pragma unroll
                    for (int kb = 0; kb < 4; ++kb) {
#pragma unroll
                        for (int r = 0; r < 4; ++r) s[kb][qs][r] *= (cfk * dfr[r] + cbk * dbr[r]);
                        cfk *= f16; cbk *= b16; }
                } else {
#pragma unroll
                    for (int kb = 0; kb < 4; ++kb) {
#pragma unroll
                        for (int r = 0; r < 4; ++r) { const float w1 = (kb * 16 + r <= tf) ? cfk * dfr[r] : 0.f, w2 = (kb * 16 + r >= tb) ? cbk * dbr[r] : 0.f; s[kb][qs][r] *= (w1 + w2); }
                        cfk *= f16; cbk *= b16; }
                }
            }
        } else if (safe) {
            float mx[2];
#pragma unroll
            for (int qs = 0; qs < 2; ++qs) {
                float m0 = fmaxf(fmaxf(s[0][qs][0], s[0][qs][1]), fmaxf(s[0][qs][2], s[0][qs][3]));
#pragma unroll
                for (int kb = 1; kb < 4; ++kb) m0 = fmaxf(m0, fmaxf(fmaxf(s[kb][qs][0], s[kb][qs][1]), fmaxf(s[kb][qs][2], s[kb][qs][3])));
                { const unsigned u = __float_as_uint(m0); const auto r1 = __builtin_amdgcn_permlane16_swap(u, u, false, false); m0 = fmaxf(__uint_as_float(r1[0]), __uint_as_float(r1[1])); }
                { const unsigned u = __float_as_uint(m0); const auto r2 = __builtin_amdgcn_permlane32_swap(u, u, false, false); m0 = fmaxf(__uint_as_float(r2[0]), __uint_as_float(r2[1])); }
                mx[qs] = m0;
            }
            const bool need = (t == 0) || (mx[0] > 8.0f) || (mx[1] > 8.0f);
            if (__builtin_amdgcn_ballot_w64(need) != 0ull) {
#pragma unroll
                for (int qs = 0; qs < 2; ++qs) {
                    const float delta = (t == 0) ? mx[qs] : fmaxf(mx[qs], 0.f);
                    const float alpha = __builtin_amdgcn_exp2f(-delta);
                    mrun[qs] += delta; Ol[qs] *= alpha;
#pragma unroll
                    for (int db = 0; db < NDB; ++db) O[db][qs] *= alpha;
#pragma unroll
                    for (int kb = 0; kb < 4; ++kb) s[kb][qs] -= delta;
                }
            }
#pragma unroll
            for (int qs = 0; qs < 2; ++qs)
#pragma unroll
                for (int kb = 0; kb < 4; ++kb)
#pragma unroll
                    for (int r = 0; r < 4; ++r) s[kb][qs][r] = __builtin_amdgcn_exp2f(s[kb][qs][r]);
        } else {
#pragma unroll
            for (int qs = 0; qs < 2; ++qs)
#pragma unroll
                for (int kb = 0; kb < 4; ++kb)
#pragma unroll
                    for (int r = 0; r < 4; ++r) s[kb][qs][r] = __builtin_amdgcn_exp2f(s[kb][qs][r]);
        }
#pragma unroll
        for (int qs = 0; qs < 2; ++qs)
#pragma unroll
            for (int j = 0; j < 2; ++j) {
                u32x4 pk; pk.x = pk_bf16(s[2 * j][qs][0], s[2 * j][qs][1]); pk.y = pk_bf16(s[2 * j][qs][2], s[2 * j][qs][3]);
                pk.z = pk_bf16(s[2 * j + 1][qs][0], s[2 * j + 1][qs][1]); pk.w = pk_bf16(s[2 * j + 1][qs][2], s[2 * j + 1][qs][3]);
                pf[qs][j] = __builtin_bit_cast(bf16x8, pk);
            }
        if (KIND != 1) {
#pragma unroll
            for (int qs = 0; qs < 2; ++qs) { Ol[qs] = __builtin_amdgcn_mfma_f32_16x16x32_bf16(ones, pf[qs][0], Ol[qs], 0, 0, 0); Ol[qs] = __builtin_amdgcn_mfma_f32_16x16x32_bf16(ones, pf[qs][1], Ol[qs], 0, 0, 0); }
        }
        if (!skew) ATT_PV(vcur);
        vprev = vcur; vcur = vnext;
      }
    }
    __syncthreads();
    if (skew) ATT_PV(vprev);
    __syncthreads();
    if (KIND == 1 || safe) break;
    { bool bad = false;
#pragma unroll
      for (int qs = 0; qs < 2; ++qs) { const float lsum = Ol[qs][0]; bad = bad || !(lsum > 1e-30f && lsum < 1e30f); }
      if (__builtin_amdgcn_ballot_w64(bad) != 0ull && lane == 0) oflag[0] = 1u;
      __syncthreads();
      const unsigned redo = oflag[0] | (ATT_FORCE == 2 ? 1u : 0u);
      __syncthreads();
      if (!redo) break;
      safe = 1; }
    }
#undef ATT_PV
#undef ATT_TR
#undef ATT_KSW
#undef ATT_LOAD
#undef ATT_STORE
    if (KIND == 1 && !isctx) {
        const bf16_t* ST = (const bf16_t*)(p.ws + WS_RST) + ((size_t)((b * 4 + head) * 8 + qb) * 2) * 8192;
#pragma unroll
        for (int dir = 0; dir < 2; ++dir) {
            bf16x8 qsf[2][2];
#pragma unroll
            for (int qs = 0; qs < 2; ++qs) {
                const int m = w * 32 + qs * 16 + lq;
                const float cq = dir ? __builtin_amdgcn_exp2f(lb2 * (float)(256 - m)) : __builtin_amdgcn_exp2f(lf2 * (float)(m + 1));
#pragma unroll
                for (int ks = 0; ks < 2; ++ks) { const u32x4 r = __builtin_bit_cast(u32x4, qf[qs][ks]);
                    u32x4 o; o.x = pk_bf16(bf_lo(r.x) * cq, bf_hi(r.x) * cq); o.y = pk_bf16(bf_lo(r.y) * cq, bf_hi(r.y) * cq); o.z = pk_bf16(bf_lo(r.z) * cq, bf_hi(r.z) * cq); o.w = pk_bf16(bf_lo(r.w) * cq, bf_hi(r.w) * cq);
                    qsf[qs][ks] = __builtin_bit_cast(bf16x8, o); }
            }
#pragma unroll
            for (int db = 0; db < NDB; ++db)
#pragma unroll
                for (int ks = 0; ks < 2; ++ks) { const bf16x8 a = *(const bf16x8*)(ST + dir * 8192 + (16 * db + lq) * 64 + ks * 32 + g * 8);
#pragma unroll
                    for (int qs = 0; qs < 2; ++qs) O[db][qs] = __builtin_amdgcn_mfma_f32_16x16x32_bf16(a, qsf[qs][ks], O[db][qs], 0, 0, 0); }
        }
    }
    float linv[2] = {1.f, 1.f};
    if (KIND != 1) {
#pragma unroll
        for (int qs = 0; qs < 2; ++qs) linv[qs] = 1.0f / Ol[qs][0];
    }
    if (KIND == 2) {
#pragma unroll
        for (int qs = 0; qs < 2; ++qs) { bf16_t* op = P + (rowbase + qn0 + qs * 16 + lq) * QKVC + 3072 + head * 64 + 4 * g;
#pragma unroll
            for (int db = 0; db < NDB; ++db) { const f32x4 o = O[db][qs] * linv[qs]; u32x2 wv; wv.x = pk_bf16(o[0], o[1]); wv.y = pk_bf16(o[2], o[3]); if (!dummy) *(u32x2*)(op + db * 16) = wv; } }
    } else if (KIND == 1) {
        const float* ng = p.ret_norm_g + l * 128;
#pragma unroll
        for (int qs = 0; qs < 2; ++qs) {
            float ss = 0.f;
#pragma unroll
            for (int db = 0; db < NDB; ++db) { const f32x4 o = O[db][qs]; ss += o[0] * o[0] + o[1] * o[1] + o[2] * o[2] + o[3] * o[3]; }
            ss += __shfl_xor(ss, 16); ss += __shfl_xor(ss, 32);
            const float rn = rsqrtf(ss * (1.0f / 128.0f) + EPS);
            bf16_t* op = P + (rowbase + qn0 + qs * 16 + lq) * QKVC + 2560 + head * 128 + 4 * g;
#pragma unroll
            for (int db = 0; db < NDB; ++db) { const u32x2 gv = *(const u32x2*)(op + db * 16); const f32x4 gn = *(const f32x4*)(ng + db * 16 + 4 * g);
                const f32x4 o = O[db][qs] * rn * gn;
                u32x2 wv; wv.x = pk_bf16(o[0] * fast_silu(bf_lo(gv.x)), o[1] * fast_silu(bf_hi(gv.x))); wv.y = pk_bf16(o[2] * fast_silu(bf_lo(gv.y)), o[3] * fast_silu(bf_hi(gv.y)));
                if (!dummy) *(u32x2*)(op + db * 16) = wv; }
        }
    } else {
        float* X = (float*)lds;
        if (comp == 1) {
#pragma unroll
            for (int qs = 0; qs < 2; ++qs)
#pragma unroll
                for (int db = 0; db < NDB; ++db)
#pragma unroll
                    for (int r = 0; r < 4; ++r) X[(((w & 3) * 64) + (qs * NDB + db) * 4 + r) * 64 + lane] = O[db][qs][r] * linv[qs];
        }
        __syncthreads();
        if (comp == 0) {
            const float lam = misc[0], osc = 1.0f - misc[1];
            const float* ng = p.diff_norm_g + l * 128;
#pragma unroll
            for (int qs = 0; qs < 2; ++qs) {
                float ss = 0.f;
#pragma unroll
                for (int db = 0; db < NDB; ++db)
#pragma unroll
                    for (int r = 0; r < 4; ++r) { const float o = O[db][qs][r] * linv[qs] - lam * X[(((w & 3) * 64) + (qs * NDB + db) * 4 + r) * 64 + lane]; O[db][qs][r] = o; ss += o * o; }
                ss += __shfl_xor(ss, 16); ss += __shfl_xor(ss, 32);
                const float rn = rsqrtf(ss * (1.0f / 128.0f) + EPS) * osc;
                bf16_t* op = P + (rowbase + qn0 + qs * 16 + lq) * QKVC + head * 128 + 4 * g;
#pragma unroll
                for (int db = 0; db < NDB; ++db) { const f32x4 gn = *(const f32x4*)(ng + db * 16 + 4 * g); const f32x4 o = O[db][qs] * rn * gn;
                    u32x2 wv; wv.x = pk_bf16(o[0], o[1]); wv.y = pk_bf16(o[2], o[3]); if (!dummy) *(u32x2*)(op + db * 16) = wv; }
            }
        }
        __syncthreads();
    }
}

__device__ __forceinline__ void attn_phase(const Params& p, unsigned char* lds, int l, int dummy) {
    bf16_t* P = (bf16_t*)(p.ws + WS_P);
    const int G = (int)gridDim.x, bx = (int)blockIdx.x;
    const int vcu = (G % 8 == 0) ? (bx % 8) * (G / 8) + bx / 8 : bx;
    const bool last = (l == DEPTH - 1);
    const int nA = last ? 1024 : 1152, nB = last ? 512 : 576, nC = last ? 1024 : 1152;
#ifndef AKMASK
#define AKMASK 7
#endif
    int idx = vcu;
    for (; idx < nA; idx += G) {
        if (!(AKMASK & 1)) continue;
        const int ic = idx >= 1024, j = idx - 1024;
        attn_item<0>(lds, P, p, l, ic ? j >> 3 : idx >> 6, ic ? (j >> 1) & 3 : (idx >> 4) & 3, ic ? j & 1 : idx & 15, ic, dummy);
    }
    for (; idx < nA + nB; idx += G) {
        if (!(AKMASK & 2)) continue;
        const int j = idx - nA;
        const int ic = j >= 512, jj = j - 512;
        attn_item<1>(lds, P, p, l, ic ? jj >> 2 : j >> 5, ic ? jj & 3 : (j >> 3) & 3, ic ? 0 : j & 7, ic, dummy);
    }
    for (; idx < nA + nB + nC; idx += G) {
        if (!(AKMASK & 4)) continue;
        const int j = idx - nA - nB;
        const int ic = j >= 1024, jj = j - 1024;
        attn_item<2>(lds, P, p, l, ic ? jj >> 3 : j >> 6, ic ? jj & 7 : (j >> 3) & 7, ic ? 0 : j & 7, ic, dummy);
    }
}

#define XB_TMO      128
#define XB_XCNT(j)  (256  + 64 * (j))
#define XB_XSUB(j)  (1280 + 64 * (j))
#define XB_XGEN(j)  (2304 + 64 * (j))
#define XB_TOP      3328
#define XB_TOPGEN   3392
#define XCD_BAR_WORDS 3456
#define XB_SPIN_CAP (1u << 18)
__device__ __forceinline__ unsigned xb_ld(unsigned* p)              { return __hip_atomic_load(p, __ATOMIC_RELAXED, __HIP_MEMORY_SCOPE_AGENT); }
__device__ __forceinline__ unsigned xb_add(unsigned* p, unsigned v) { return __hip_atomic_fetch_add(p, v, __ATOMIC_RELAXED, __HIP_MEMORY_SCOPE_AGENT); }
__device__ __forceinline__ unsigned xb_xcc_id() { return (unsigned)__builtin_amdgcn_s_getreg((3 << 11) | 20) & 0xFu; }
#define XB_SPIN(cond, bar) do { unsigned _sp = 0; while (cond) { __builtin_amdgcn_s_sleep(1); \
    if ((++_sp & 255u) == 0u) { if (xb_ld(&(bar)[XB_TMO])) break; if (_sp > XB_SPIN_CAP) { atomicAdd(&(bar)[XB_TMO], 1u); break; } } } } while (0)
struct XcdBarrier { unsigned* bar; unsigned x; volatile LAS unsigned* st; };
__device__ __forceinline__ XcdBarrier xcd_barrier_post(unsigned* bar, volatile LAS unsigned* st) {
    XcdBarrier b; b.bar = bar; b.x = xb_xcc_id(); b.st = st;
    if (threadIdx.x == 0) (void)xb_add(&bar[XB_XCNT(b.x)], 1u);
    return b;
}
__device__ __forceinline__ void xcd_barrier_complete(unsigned* bar, unsigned x, unsigned& nloc, unsigned& nx) {
    const unsigned G = gridDim.x * gridDim.y * gridDim.z;
    unsigned sum, cnt, mine, sp = 0u;
    for (;;) {
        sum = 0u; cnt = 0u; mine = 0u;
#pragma unroll
        for (unsigned j = 0; j < 16; ++j) { const unsigned c = xb_ld(&bar[XB_XCNT(j)]); sum += c; cnt += (c > 0u) ? 1u : 0u; mine = (j == x) ? c : mine; }
        if (sum == G) break;
        __builtin_amdgcn_s_sleep(1);
        if ((++sp & 255u) == 0u) { if (xb_ld(&bar[XB_TMO])) break; if (sp > XB_SPIN_CAP) { atomicAdd(&bar[XB_TMO], 1u); break; } }
    }
    nloc = mine > 0u ? mine : 1u; nx = cnt > 0u ? cnt : 1u;
}
__device__ __forceinline__ void xcd_barrier(const XcdBarrier& b) {
    asm volatile("s_waitcnt vmcnt(0)" ::: "memory");
    __syncthreads();
    if (threadIdx.x == 0) {
        unsigned* bar = b.bar;
        __builtin_amdgcn_s_waitcnt(0);
        unsigned nloc = b.st[0], nx = b.st[1];
        if (nloc == 0u) { xcd_barrier_complete(bar, b.x, nloc, nx); b.st[0] = nloc; b.st[1] = nx; }
        const unsigned old = xb_add(&bar[XB_XSUB(b.x)], 1u);
        const unsigned gen = old / nloc;
        if (old + 1u == (gen + 1u) * nloc) {
            __builtin_amdgcn_fence(__ATOMIC_RELEASE, "agent");
            asm volatile("s_waitcnt vmcnt(0)" ::: "memory");
            const unsigned og = xb_add(&bar[XB_TOP], 1u);
            const unsigned tg = og / nx;
            if (og + 1u == (tg + 1u) * nx) xb_add(&bar[XB_TOPGEN], 1u);
            else XB_SPIN(xb_ld(&bar[XB_TOPGEN]) == tg, bar);
            __builtin_amdgcn_fence(__ATOMIC_ACQUIRE, "agent");
            xb_add(&bar[XB_XGEN(b.x)], 1u);
            asm volatile("s_waitcnt vmcnt(0)" ::: "memory");
        } else {
            XB_SPIN(xb_ld(&bar[XB_XGEN(b.x)]) == gen, bar);
            __builtin_amdgcn_fence(__ATOMIC_ACQUIRE, "agent");
            asm volatile("s_waitcnt vmcnt(0)" ::: "memory");
        }
    }
    __syncthreads();
}

constexpr int PPL = 13;
constexpr int NPH = 2 + PPL * DEPTH;
__device__ __forceinline__ int phase_k(int pos) { return pos < 4 ? pos : (pos == 4 ? 12 : (pos == 5 ? 13 : pos - 1)); }

__device__ __forceinline__ void run_phase(const Params& p, unsigned char* lds, int ph, int dummy) {
    float* lf = (float*)lds;
    LAS unsigned char* ldsl = (LAS unsigned char*)lds;
    bf16_t* P = (bf16_t*)(p.ws + WS_P);
    bf16_t* Y = (bf16_t*)(p.ws + WS_Y);
    unsigned char* G8 = p.ws + WS_G8;
#ifndef PHMASK
#define PHMASK 0xffff
#endif
    if (ph == 0 && (PHMASK & 1)) {
        const int total = 288 + 1 + CONV_FFN_TILES;
        unsigned* ctr = (unsigned*)(p.ws + WS_BAR) + 3600;
        volatile LAS unsigned* slot = (volatile LAS unsigned*)((LAS unsigned char*)lds + LDS_MAIN) + 2;
        for (;;) {
            if (threadIdx.x == 0) slot[0] = atomicAdd(ctr, 1u);
            __syncthreads();
            const int it = (int)slot[0];
            __syncthreads();
            if (it >= total) break;
            if (it < 288) mod_item(p, lf, it);
            else if (it == 288) misc_item(p);
            else conv_ffn(p, lf, 0, 0, it - 289);
        }
        return;
    }
    if (ph == 0) return;
    if (ph == 1) { if (PHMASK & 2) ephase_rows(p, true, true, 0, 0, 0.f, Y, false, 0, 0, false, dummy); return; }
    const int l = (ph - 2) / PPL, k = phase_k((ph - 2) % PPL);
    const bool last = (l == DEPTH - 1);
    switch (k) {
    case 0: case 9: if (PHMASK & 4) {
        const int lat = (k == 9 && last) ? 1 : 0;
        pg8::Gemm g{Y, (const bf16_t*)(p.ws + WS_WFI), DM, DM, DM, 0};
        pg8::Order S; S.init(lat ? 128 : 144, 22, lat, 1, DM, DM); S.ntfull = DM / 64;
        pg8::EpiSwiglu E{P};
        pg8::gemm_phase<pg8::EpiSwiglu>(ldsl, g, S, E);
        if (k == 0 && l == 0) conv_tail(p, lds, 6, CONV_MIX_TILES, 1, 0, 0);
        if (k == 9 && !last) conv_tail(p, lds, 4 + l, CONV_MIX_TILES, 1, l + 1, 0);
    } break;
    case 1: case 7: case 10: if (PHMASK & 8) {
        const int lat = (k != 1 && last) ? 1 : 0;
        bf16_t* part = (bf16_t*)(p.ws + WS_PART);
        pg8::Gemm g; pg8::EpiPlain E;
        if (k == 7) { g = pg8::Gemm{Y, (const bf16_t*)(p.ws + WS_WMO), DM, DM, DM, 0}; E = pg8::EpiPlain{P, DM, part}; }
        else { g = pg8::Gemm{P, (const bf16_t*)(p.ws + WS_WFO), DFF, DFF, DFF, 0}; E = pg8::EpiPlain{Y, DM, part}; }
        pg8::Order S; S.init(128, 4, 1, 1, g.lda, g.ldb); S.ntfull = g.K / 64;
        if (!lat) { S.extra = 256; S.xmode = 2; S.nchunks = g.K / 128; }
        pg8::gemm_phase<pg8::EpiPlain>(ldsl, g, S, E);
    } break;
    case 2: case 8: case 11: if (PHMASK & 2) {
        if (k == 11) { if (!last) for (int it = blockIdx.x; it < CONV_FFN_TILES; it += gridDim.x) conv_ffn(p, lf, l + 1, 0, it); }
        if (k == 2) ephase_rows(p, false, l == 0, l, 0, 0.5f, Y, true, l, 1, false, dummy);
        else if (k == 8) ephase_rows(p, false, false, l, 1, 1.0f, P, !last, l, 2, last, dummy);
        else ephase_rows(p, false, false, l, 2, 0.5f, Y, !last, last ? l : l + 1, last ? -1 : 0, last, dummy);
    } break;
    case 3: if (PHMASK & 16) {
        pg8::Gemm g{Y, (const bf16_t*)(p.ws + WS_WMI), DM, DM, DM, 0};
        pg8::Order S; S.init(last ? 128 : 144, 27, last ? 1 : 0, 1, DM, DM); S.ntfull = DM / 64;
        if (last) S.extra = 128;
        pg8::EpiQkvGate E{P, G8, p.b_gate + (size_t)l * GATEC, (const f32x2*)(p.ws + WS_ROPE), p.qk_norm_g + (size_t)(l * 2 + 1) * 64};
        pg8::gemm_phase<pg8::EpiQkvGate>(ldsl, g, S, E);
        conv_tail(p, lds, 1 + l, CONV_FFN_TILES, 0, l, 1);
    } break;
    case 4: if (PHMASK & 32) rope_phase(p, l, dummy); break;
    case 5: if (PHMASK & 64) attn_phase(p, lds, l, dummy); break;
    case 12: if (PHMASK & 64) rs1_phase(p, lds, l); break;
    case 13: if (PHMASK & 64) rs2_phase(p, l); break;
    case 6: if (PHMASK & 128) {
        const int lat = last ? 1 : 0;
        pg8::Gemm g{P, (const bf16_t*)(p.ws + WS_WMB), QKVC, 512, 512, 0};
        pg8::Order S; S.init(lat ? 128 : 144, 4, lat, 1, QKVC, 512); S.ntfull = 24;
        pg8::EpiMerge E{Y, G8};
        pg8::gemm_phase<pg8::EpiMerge, true>(ldsl, g, S, E, 2560 * 2, 512 * 2, (size_t)DM * 512 * 2);
    } break;
    }
}

__global__ void __launch_bounds__(NTHREADS) mk_fwd(Params p) {
    extern __shared__ __attribute__((aligned(16))) unsigned char lds[];
    volatile LAS unsigned* st = (volatile LAS unsigned*)((LAS unsigned char*)lds + LDS_MAIN);
    const bool multi = (p.ph_hi - p.ph_lo) > 1;
    XcdBarrier bar; bar.bar = (unsigned*)(p.ws + WS_BAR); bar.x = 0; bar.st = st;
    if (multi) {
        if (threadIdx.x < 4) st[threadIdx.x] = 0u;
        __syncthreads();
        bar = xcd_barrier_post((unsigned*)(p.ws + WS_BAR), st);
    }
    for (int ph = p.ph_lo; ph < p.ph_hi; ++ph) {
        int nrep = 1;
        if (PROBE_DUP) {
            const int k = ph < 2 ? -1 : phase_k((ph - 2) % PPL);
            const int kind = ph == 0 ? 1 : (ph == 1 || k == 2 || k == 8 || k == 11) ? 2 : (k == 0 || k == 9) ? 4 : (k == 1 || k == 7 || k == 10) ? 8 : k == 3 ? 16 : k == 4 ? 32 : (k == 5 || k >= 12) ? 64 : 128;
            if ((PROBE_DUP & kind) && p.probe) nrep = 2;
        }
        unsigned long long amp_t0 = 0ull; bool amp = false;
        if (PROBE_AMP) {
            const int k = ph < 2 ? -1 : phase_k((ph - 2) % PPL);
            const int kind = ph == 0 ? 1 : (ph == 1 || k == 2 || k == 8 || k == 11) ? 2 : (k == 0 || k == 9) ? 4 : (k == 1 || k == 7 || k == 10) ? 8 : k == 3 ? 16 : k == 4 ? 32 : (k == 5 || k >= 12) ? 64 : 128;
            amp = (PROBE_AMP & kind) && p.probe && (ph + 1 < p.ph_hi);
            if (amp) amp_t0 = __builtin_amdgcn_s_memrealtime();
        }
        for (int rep = 0; rep < nrep; ++rep) run_phase(p, lds, ph, rep + 1 < nrep ? 1 : 0);
        if (ph + 1 < p.ph_hi) {
            if (p.ph_hi > 1000) cg::this_grid().sync();
            xcd_barrier(bar);
            if ((PROBE_DUP & 256) && p.probe) xcd_barrier(bar);
            if (PROBE_AMP && amp) { const unsigned long long t1 = __builtin_amdgcn_s_memrealtime(); const unsigned long long until = t1 + 4ull * (t1 - amp_t0); while (__builtin_amdgcn_s_memrealtime() < until) __builtin_amdgcn_s_sleep(8); }
        }
    }
}

extern "C" void kernel_launch(void* const* d_in, const int* in_sizes, int n_in, void* d_out, int out_size, void* d_ws, size_t ws_size, hipStream_t stream) {
    static int grid = 0;
    if (grid == 0) {
        if (ws_size < WS_END) { fprintf(stderr, "kernel_launch: workspace too small: %zu < %zu\n", ws_size, (size_t)WS_END); grid = -1; return; }
        int dev = 0, cus = 0, per_cu = 0;
        hipGetDevice(&dev);
        hipDeviceGetAttribute(&cus, hipDeviceAttributeMultiprocessorCount, dev);
        if (hipFuncSetAttribute((const void*)mk_fwd, hipFuncAttributeMaxDynamicSharedMemorySize, LDS_BYTES) != hipSuccess) { fprintf(stderr, "kernel_launch: hipFuncSetAttribute failed\n"); grid = -1; return; }
        if (hipOccupancyMaxActiveBlocksPerMultiprocessor(&per_cu, (const void*)mk_fwd, NTHREADS, LDS_BYTES) != hipSuccess || per_cu < 1) { fprintf(stderr, "kernel_launch: occupancy query gave %d\n", per_cu); per_cu = 1; }
        (void)hipGetLastError();
        grid = cus * 1;
        if (grid <= 0) grid = 256;
    }
    if (grid < 0) return;
    Params p{};
    p.x = (const float*)d_in[0]; p.c = (const float*)d_in[1]; p.ctx = (const float*)d_in[2]; p.c_ctx = (const float*)d_in[3];
    p.w_mod = (const float*)d_in[4]; p.b_mod = (const float*)d_in[5]; p.norm_g = (const float*)d_in[6]; p.w_ffn_in = (const float*)d_in[7];
    p.w_ffn_out = (const float*)d_in[8]; p.w_in = (const float*)d_in[9]; p.b_gate = (const float*)d_in[10]; p.diff_lambda = (const float*)d_in[11];
    p.diff_norm_g = (const float*)d_in[12]; p.ret_logit = (const float*)d_in[13]; p.ret_norm_g = (const float*)d_in[14]; p.qk_norm_g = (const float*)d_in[15];
    p.w_branch = (const float*)d_in[16]; p.w_out = (const float*)d_in[17];
    p.out = (float*)d_out; p.ws = (unsigned char*)d_ws; p.probe = (PROBE_DUP || PROBE_AMP) ? 1 : 0;
    if (hipMemsetAsync((char*)d_ws + WS_BAR, 0, 16384, stream) != hipSuccess) { fprintf(stderr, "kernel_launch: memset of barrier / counter words failed\n"); return; }
#if MK_PER_PHASE
    for (int ph = 0; ph < NPH; ++ph) {
        p.ph_lo = ph; p.ph_hi = ph + 1;
        hipLaunchKernelGGL(mk_fwd, dim3(grid), dim3(NTHREADS), LDS_BYTES, stream, p);
    }
#else
    p.ph_lo = 0; p.ph_hi = NPH;
    void* args[] = {&p};
    hipError_t e = hipLaunchCooperativeKernel((const void*)mk_fwd, dim3(grid), dim3(NTHREADS), args, LDS_BYTES, stream);
    if (e != hipSuccess) fprintf(stderr, "cooperative launch failed: %s (grid %d)\n", hipGetErrorString(e), grid);
#endif
}
```

```cpp
#include <hip/hip_runtime.h>
#include <hip/hip_cooperative_groups.h>
#include <cstdio>
#include <cstdint>
namespace cg = cooperative_groups;

#ifndef PROBE_DUP
#define PROBE_DUP 0
#endif
#ifndef PROBE_AMP
#define PROBE_AMP 0
#endif
#ifndef ATT_FORCE
#define ATT_FORCE 0
#endif
#ifndef ATT_SKEW
#define ATT_SKEW 1
#endif
#ifndef MK_PER_PHASE
#define MK_PER_PHASE 0
#endif

#define LAS __attribute__((address_space(3)))
typedef unsigned short bf16_t;
typedef short bf16x8 __attribute__((ext_vector_type(8)));
typedef short s16x4 __attribute__((ext_vector_type(4)));
typedef float f32x4 __attribute__((ext_vector_type(4)));
typedef float f32x2 __attribute__((ext_vector_type(2)));
typedef unsigned u32x4 __attribute__((ext_vector_type(4)));
typedef unsigned u32x2 __attribute__((ext_vector_type(2)));
typedef __bf16 bf16v2 __attribute__((ext_vector_type(2)));

constexpr int DM = 1024, NB = 16, SEQ = 2048, CTXL = 256, TPB = 2304, NT = NB * TPB, DFF = 2816, DEPTH = 2;
constexpr int QKVC = 3840, GATEC = 3072, INC = 6912, MODC = 9216;
constexpr float EPS = 1e-6f;
constexpr int NTHREADS = 512;
constexpr int LDS_MAIN = 131072;
constexpr int LDS_BYTES = LDS_MAIN + 16;

constexpr size_t WS_P    = 0;
constexpr size_t WS_G8   = WS_P + (size_t)NT * QKVC * 2;
constexpr size_t WS_Y    = WS_G8 + (size_t)NT * GATEC;
constexpr size_t WS_HC   = WS_Y + (size_t)NT * DM * 2;
constexpr size_t WS_WFI  = WS_HC + (size_t)NB * CTXL * DM * 4;
constexpr size_t WS_WFO  = WS_WFI + (size_t)2 * DFF * DM * 2;
constexpr size_t WS_WMI  = WS_WFO + (size_t)DM * DFF * 2;
constexpr size_t WS_WMB  = WS_WMI + (size_t)INC * DM * 2;
constexpr size_t WS_WMO  = WS_WMB + (size_t)3 * DM * 512 * 2;
constexpr size_t WS_MOD  = WS_WMO + (size_t)DM * DM * 2;
constexpr size_t WS_ROPE = WS_MOD + (size_t)DEPTH * 17 * MODC * 4;
constexpr size_t WS_MISC = WS_ROPE + 64 * 16 * 8;
constexpr size_t WS_BAR  = WS_MISC + 1024;
constexpr size_t WS_END  = WS_BAR + 16384;
constexpr size_t WS_PART = WS_P + (size_t)208 * 1024 * 1024;
constexpr size_t WS_RSU  = WS_Y;
constexpr size_t WS_RST  = WS_Y + (size_t)40 * 1024 * 1024;

struct Params {
    const float *x, *c, *ctx, *c_ctx, *w_mod, *b_mod, *norm_g, *w_ffn_in, *w_ffn_out, *w_in, *b_gate,
                *diff_lambda, *diff_norm_g, *ret_logit, *ret_norm_g, *qk_norm_g, *w_branch, *w_out;
    float* out; unsigned char* ws; int ph_lo, ph_hi, probe, pad;
};

__device__ __forceinline__ int opaque_tid() { int t = (int)threadIdx.x; asm volatile("" : "+v"(t)); return t; }
__device__ __forceinline__ int opaque_bid() { int t = (int)blockIdx.x; asm volatile("" : "+s"(t)); return t; }
__device__ __forceinline__ unsigned pk_bf16(float lo, float hi) { f32x2 v = {lo, hi}; bf16v2 r = __builtin_convertvector(v, bf16v2); return __builtin_bit_cast(unsigned, r); }
__device__ __forceinline__ float bf_lo(unsigned u) { return __uint_as_float(u << 16); }
__device__ __forceinline__ float bf_hi(unsigned u) { return __uint_as_float(u & 0xffff0000u); }
__device__ __forceinline__ float wave_sum(float v) {
    v += __shfl_xor(v, 32); v += __shfl_xor(v, 16); v += __shfl_xor(v, 8); v += __shfl_xor(v, 4); v += __shfl_xor(v, 2); v += __shfl_xor(v, 1); return v; }
__device__ __forceinline__ float fast_sigmoid(float a) { return __builtin_amdgcn_rcpf(1.0f + __builtin_amdgcn_exp2f(a * -1.4426950408889634f)); }
__device__ __forceinline__ float fast_silu(float a) { return a * fast_sigmoid(a); }

namespace pg8 {
constexpr int BM = 256, BK = 64, HALF = 128, HTB = HALF * BK * 2, STAGE_BYTES = 8 * HTB, NXCD = 8, WGM = 8;
__device__ __forceinline__ int lds_byte(int r, int c) { const int st = (r >> 4) * 2 + (c >> 5), rr = r & 15, cc = c & 31, ob = rr * 64 + cc * 2; return st * 1024 + (ob ^ (((ob >> 9) & 1) << 5)); }
__device__ __forceinline__ void stage_rc(int b, int& R, int& C) { const int st = b / 1024, sb = b % 1024, swz = sb ^ (((sb >> 9) & 1) << 5); R = (st >> 1) * 16 + swz / 64; C = (st & 1) * 32 + (swz % 64) / 2; }
__device__ __forceinline__ int perm32(int rho) { const int n = rho >> 4, i = rho & 15; return 8 * (i >> 2) + 4 * n + (i & 3); }

struct Unit { int pm, pn, br, nt; size_t aoff, boff; };
struct Gemm { const bf16_t* A; const bf16_t* Bt; int lda, ldb, K, pad; };

struct Order {
    int nM, nN, nwg, G, c, latent_only, reps, extra, xmode, ntfull, nchunks, pad;
    size_t a_tile, b_tile, a_rep0, a_rep1, a_rep2, b_rep;
    __device__ __forceinline__ void init(int nM_, int nN_, int latent_only_, int reps_, int lda, int ldb, size_t ar1 = 0, size_t ar2 = 0, size_t brep = 0) {
        nM = nM_; nN = nN_; nwg = nM * nN; G = (int)gridDim.x; c = opaque_bid(); latent_only = latent_only_; reps = reps_; extra = 0; xmode = 1; ntfull = 0; nchunks = 0; pad = 0;
        a_tile = (size_t)BM * lda * 2; b_tile = (size_t)BM * ldb * 2; a_rep0 = 0; a_rep1 = ar1; a_rep2 = ar2 - ar1; b_rep = brep;
    }
    __device__ __forceinline__ bool next(int i, Unit& u) const {
        int it = i, br = 0;
        if (reps == 3) { it = i / 3; br = i - it * 3; }
        const long L = (long)it * G + c; if (L >= nwg + extra) return false;
        if (L >= nwg) {
            const int j = (int)(L - nwg);
            if (xmode == 2) {
                const int cu = j >> 2, part = j & 3, base = nchunks >> 2, rem = nchunks & 3;
                const int start = part * base + (part < rem ? part : rem), size = base + (part < rem ? 1 : 0);
                u.pm = (cu >> 2) * 9 + 8; u.pn = cu & 3; u.br = part + 1; u.nt = size * 2;
                u.aoff = (size_t)u.pm * a_tile + (size_t)start * 256; u.boff = (size_t)u.pn * b_tile + (size_t)start * 256; return true;
            }
            u.pm = (j >> 3) * 9 + 8; u.pn = (int)((0xE9875432u >> (4 * (j & 7))) & 15u); u.br = 0; u.nt = ntfull;
            u.aoff = (size_t)u.pm * a_tile; u.boff = (size_t)u.pn * b_tile; return true;
        }
        int wgid = (int)L; { const int q = nwg / NXCD, r = nwg % NXCD, xcd = wgid % NXCD, off = wgid / NXCD; wgid = (xcd < r ? xcd * (q + 1) : r * (q + 1) + (xcd - r) * q) + off; }
        const int nig = WGM * nN, gid = wgid / nig, fm = gid * WGM, gsz = (nM - fm) < WGM ? (nM - fm) : WGM;
        const int pmv = fm + ((wgid % nig) % gsz); u.pn = (wgid % nig) / gsz;
        u.pm = latent_only ? (pmv >> 3) * 9 + (pmv & 7) : pmv; u.br = br; u.nt = ntfull;
        u.aoff = (size_t)u.pm * a_tile + (size_t)(br > 0 ? 1 : 0) * (a_rep1 + (size_t)(br - 1) * a_rep2);
        u.boff = (size_t)u.pn * b_tile + (size_t)br * b_rep;
        return true;
    }
};


struct EpiPlain {
    bf16_t* O; int ldc; bf16_t* Opart;
    __device__ __forceinline__ void operator()(const f32x4 (&acc)[2][2][4][2], const Unit& u, int wr, int wc, int fr, int fq) const {
        const int col0 = u.pn * BM + wc * 32 + 8 * fq;
        bf16_t* base = O + (size_t)(u.pm * BM + wr * 64 + fr) * ldc + col0;
        if (u.br > 0) base = Opart + ((size_t)(u.br - 1) * (NB * CTXL) + (size_t)((u.pm / 9) * BM + wr * 64 + fr)) * DM + col0;
#pragma unroll
        for (int ai = 0; ai < 2; ++ai)
#pragma unroll
            for (int m = 0; m < 4; ++m) { bf16_t* rowp = base + (size_t)(ai * HALF + m * 16) * ldc;
#pragma unroll
                for (int bj = 0; bj < 2; ++bj) { const f32x4 v0 = acc[ai][bj][m][0], v1 = acc[ai][bj][m][1];
                    u32x4 w; w.x = pk_bf16(v0[0], v0[1]); w.y = pk_bf16(v0[2], v0[3]); w.z = pk_bf16(v1[0], v1[1]); w.w = pk_bf16(v1[2], v1[3]);
                    *(u32x4*)(rowp + bj * HALF) = w; } }
    }
};
struct EpiSwiglu {
    bf16_t* O;
    __device__ __forceinline__ void operator()(const f32x4 (&acc)[2][2][4][2], const Unit& u, int wr, int wc, int fr, int fq) const {
        const int row0 = u.pm * BM + wr * 64 + fr, col0 = u.pn * HALF + wc * 32 + 8 * fq;
#pragma unroll
        for (int ai = 0; ai < 2; ++ai)
#pragma unroll
            for (int m = 0; m < 4; ++m) { bf16_t* rowp = O + (size_t)(row0 + ai * HALF + m * 16) * DFF + col0;
                const f32x4 a0 = acc[ai][0][m][0], a1 = acc[ai][0][m][1], g0 = acc[ai][1][m][0], g1 = acc[ai][1][m][1];
                u32x4 w; w.x = pk_bf16(fast_silu(a0[0]) * g0[0], fast_silu(a0[1]) * g0[1]); w.y = pk_bf16(fast_silu(a0[2]) * g0[2], fast_silu(a0[3]) * g0[3]);
                w.z = pk_bf16(fast_silu(a1[0]) * g1[0], fast_silu(a1[1]) * g1[1]); w.w = pk_bf16(fast_silu(a1[2]) * g1[2], fast_silu(a1[3]) * g1[3]);
                *(u32x4*)rowp = w; }
    }
};
struct EpiQkvGate {
    bf16_t* P; unsigned char* G8; const float* bgate; const f32x2* rope; const float* knorm;
    __device__ __forceinline__ void operator()(const f32x4 (&acc)[2][2][4][2], const Unit& u, int wr, int wc, int fr, int fq) const {
        const int row0 = u.pm * BM + wr * 64 + fr;
        if (u.pn == 2 || u.pn == 3 || u.pn == 7 || u.pn == 14) {
            const bool lat = (u.pm % 9) != 8;
            const bool isv = (u.pn == 14) && (wc >= 2), cnorm = (u.pn == 14) && (wc < 2);
            const int c1 = isv ? 3712 + (wc - 2) * 32 + 8 * fq : (u.pn == 14 ? 3584 : u.pn * BM) + wc * 64 + 8 * fq, c2 = isv ? c1 + 64 : c1 + 32;
#pragma unroll
            for (int ai = 0; ai < 2; ++ai)
#pragma unroll
                for (int m = 0; m < 4; ++m) { const int row = row0 + ai * HALF + m * 16; bf16_t* rowp = P + (size_t)row * QKVC;
                    f32x4 a0 = acc[ai][0][m][0], a1 = acc[ai][0][m][1], b0 = acc[ai][1][m][0], b1 = acc[ai][1][m][1];
                    if (!isv) {
                        if (cnorm) {
                            float ss = 0.f;
#pragma unroll
                            for (int j = 0; j < 4; ++j) ss += a0[j] * a0[j] + a1[j] * a1[j] + b0[j] * b0[j] + b1[j] * b1[j];
                            ss += __shfl_xor(ss, 16); ss += __shfl_xor(ss, 32);
                            const float r = rsqrtf(ss * (1.0f / 64.0f) + EPS);
                            const f32x4 g0 = *(const f32x4*)(knorm + 8 * fq), g1 = *(const f32x4*)(knorm + 8 * fq + 4), g2 = *(const f32x4*)(knorm + 32 + 8 * fq), g3 = *(const f32x4*)(knorm + 36 + 8 * fq);
                            a0 *= r * g0; a1 *= r * g1; b0 *= r * g2; b1 *= r * g3;
                        }
                        if (lat) {
                            const int n = row % TPB; const int pos = (fq < 2) ? (n >> 6) : (n & 63);
                            const f32x4* cs = (const f32x4*)(rope + pos * 16 + (fq & 1) * 8);
                            const f32x4 t0 = cs[0], t1 = cs[1], t2 = cs[2], t3 = cs[3];
                            const f32x4 co0 = (f32x4){t0[0], t0[2], t1[0], t1[2]}, si0 = (f32x4){t0[1], t0[3], t1[1], t1[3]};
                            const f32x4 co1 = (f32x4){t2[0], t2[2], t3[0], t3[2]}, si1 = (f32x4){t2[1], t2[3], t3[1], t3[3]};
                            const f32x4 x0 = a0 * co0 - b0 * si0, y0 = a0 * si0 + b0 * co0, x1 = a1 * co1 - b1 * si1, y1 = a1 * si1 + b1 * co1;
                            a0 = x0; b0 = y0; a1 = x1; b1 = y1;
                        }
                    }
                    u32x4 w1, w2; w1.x = pk_bf16(a0[0], a0[1]); w1.y = pk_bf16(a0[2], a0[3]); w1.z = pk_bf16(a1[0], a1[1]); w1.w = pk_bf16(a1[2], a1[3]);
                    w2.x = pk_bf16(b0[0], b0[1]); w2.y = pk_bf16(b0[2], b0[3]); w2.z = pk_bf16(b1[0], b1[1]); w2.w = pk_bf16(b1[2], b1[3]);
                    *(u32x4*)(rowp + c1) = w1; *(u32x4*)(rowp + c2) = w2; }
        } else if (u.pn < 15) {
            const int col0 = u.pn * BM + wc * 32 + 8 * fq;
#pragma unroll
            for (int ai = 0; ai < 2; ++ai)
#pragma unroll
                for (int m = 0; m < 4; ++m) { bf16_t* rowp = P + (size_t)(row0 + ai * HALF + m * 16) * QKVC + col0;
#pragma unroll
                    for (int bj = 0; bj < 2; ++bj) { const f32x4 v0 = acc[ai][bj][m][0], v1 = acc[ai][bj][m][1];
                        u32x4 w; w.x = pk_bf16(v0[0], v0[1]); w.y = pk_bf16(v0[2], v0[3]); w.z = pk_bf16(v1[0], v1[1]); w.w = pk_bf16(v1[2], v1[3]);
                        *(u32x4*)(rowp + bj * HALF) = w; } }
        } else {
            const int col0 = (u.pn - 15) * BM + wc * 64 + 16 * fq;
            f32x4 bv[2][2];
#pragma unroll
            for (int bj = 0; bj < 2; ++bj)
#pragma unroll
                for (int n = 0; n < 2; ++n) bv[bj][n] = *(const f32x4*)(bgate + col0 + bj * 8 + 4 * n);
#pragma unroll
            for (int ai = 0; ai < 2; ++ai)
#pragma unroll
                for (int m = 0; m < 4; ++m) { unsigned char* rowp = G8 + (size_t)(row0 + ai * HALF + m * 16) * GATEC + col0;
                    unsigned wq[4];
#pragma unroll
                    for (int bj = 0; bj < 2; ++bj)
#pragma unroll
                        for (int n = 0; n < 2; ++n) { const f32x4 v = acc[ai][bj][m][n] + bv[bj][n]; unsigned q[4];
#pragma unroll
                            for (int j = 0; j < 4; ++j) q[j] = max(1u, (unsigned)__float2uint_rn(fast_sigmoid(v[j]) * 255.0f));
                            wq[bj * 2 + n] = q[0] | (q[1] << 8) | (q[2] << 16) | (q[3] << 24); }
                    *(u32x4*)rowp = (u32x4){wq[0], wq[1], wq[2], wq[3]}; }
        }
    }
};
struct EpiMerge {
    bf16_t* O; const unsigned char* G8;
    __device__ __forceinline__ void hook(f32x4 (&acc)[2][2][4][2], const Unit& u, int sg, int wr, int wc, int fr, int fq) const {
        const int row0 = u.pm * BM + wr * 64 + fr, col0 = u.pn * BM + wc * 32 + 8 * fq;
        const unsigned char* gbase = G8 + (size_t)row0 * GATEC + (sg - 1) * DM + col0;
#pragma unroll
        for (int ai = 0; ai < 2; ++ai)
#pragma unroll
            for (int mp = 0; mp < 2; ++mp) {
                u32x2 qa[2][2], qb[2][2];
#pragma unroll
                for (int mm = 0; mm < 2; ++mm) { const unsigned char* gp = gbase + (size_t)(ai * HALF + (mp * 2 + mm) * 16) * GATEC;
#pragma unroll
                    for (int bj = 0; bj < 2; ++bj) { qa[mm][bj] = *(const u32x2*)(gp + bj * HALF); qb[mm][bj] = *(const u32x2*)(gp + DM + bj * HALF); } }
#pragma unroll
                for (int mm = 0; mm < 2; ++mm)
#pragma unroll
                    for (int bj = 0; bj < 2; ++bj) { const u32x2 a = qa[mm][bj], b = qb[mm][bj]; const int m = mp * 2 + mm;
                        f32x4 r0, r1;
                        r0[0] = (float)(a.x & 255u) * __builtin_amdgcn_rcpf((float)(b.x & 255u)); r0[1] = (float)((a.x >> 8) & 255u) * __builtin_amdgcn_rcpf((float)((b.x >> 8) & 255u));
                        r0[2] = (float)((a.x >> 16) & 255u) * __builtin_amdgcn_rcpf((float)((b.x >> 16) & 255u)); r0[3] = (float)(a.x >> 24) * __builtin_amdgcn_rcpf((float)(b.x >> 24));
                        r1[0] = (float)(a.y & 255u) * __builtin_amdgcn_rcpf((float)(b.y & 255u)); r1[1] = (float)((a.y >> 8) & 255u) * __builtin_amdgcn_rcpf((float)((b.y >> 8) & 255u));
                        r1[2] = (float)((a.y >> 16) & 255u) * __builtin_amdgcn_rcpf((float)((b.y >> 16) & 255u)); r1[3] = (float)(a.y >> 24) * __builtin_amdgcn_rcpf((float)(b.y >> 24));
                        acc[ai][bj][m][0] *= r0; acc[ai][bj][m][1] *= r1; }
                asm volatile("" ::: "memory");
            }
    }
    __device__ __forceinline__ void operator()(const f32x4 (&acc)[2][2][4][2], const Unit& u, int wr, int wc, int fr, int fq) const {
        const int row0 = u.pm * BM + wr * 64 + fr, col0 = u.pn * BM + wc * 32 + 8 * fq;
        const float s = 1.0f / 255.0f;
#pragma unroll
        for (int ai = 0; ai < 2; ++ai) {
            u32x2 gq[4][2];
#pragma unroll
            for (int m = 0; m < 4; ++m) { const size_t r = (size_t)(row0 + ai * HALF + m * 16);
#pragma unroll
                for (int bj = 0; bj < 2; ++bj) gq[m][bj] = *(const u32x2*)(G8 + r * GATEC + 2 * DM + col0 + bj * HALF); }
#pragma unroll
            for (int m = 0; m < 4; ++m) { const size_t r = (size_t)(row0 + ai * HALF + m * 16);
#pragma unroll
                for (int bj = 0; bj < 2; ++bj) { const f32x4 v0 = acc[ai][bj][m][0], v1 = acc[ai][bj][m][1]; const u32x2 g = gq[m][bj];
                    float o[8];
                    o[0] = v0[0] * (s * (float)(g.x & 255u)); o[1] = v0[1] * (s * (float)((g.x >> 8) & 255u));
                    o[2] = v0[2] * (s * (float)((g.x >> 16) & 255u)); o[3] = v0[3] * (s * (float)(g.x >> 24));
                    o[4] = v1[0] * (s * (float)(g.y & 255u)); o[5] = v1[1] * (s * (float)((g.y >> 8) & 255u));
                    o[6] = v1[2] * (s * (float)((g.y >> 16) & 255u)); o[7] = v1[3] * (s * (float)(g.y >> 24));
                    u32x4 w; w.x = pk_bf16(o[0], o[1]); w.y = pk_bf16(o[2], o[3]); w.z = pk_bf16(o[4], o[5]); w.w = pk_bf16(o[6], o[7]);
                    *(u32x4*)(O + r * DM + col0 + bj * HALF) = w; } }
        }
    }
};

template <class Epi, bool SEG = false>
__device__ __forceinline__ void gemm_phase(LAS unsigned char* lds, const Gemm g, const Order& S, const Epi& E, const size_t ar1 = 0, const size_t ar2 = 0, const size_t brep = 0) {
    const int tid = opaque_tid(), wid = __builtin_amdgcn_readfirstlane(tid >> 6), lane = tid & 63, wr = wid >> 2, wc = wid & 3, fr = lane & 15, fq = lane >> 4;
    const int K = g.K; (void)K;
    unsigned voffA[2], voffB[2];
#pragma unroll
    for (int i = 0; i < 2; ++i) { int R, C; stage_rc(tid * 16 + i * 8192, R, C); const int Rb = (R & ~31) + perm32(R & 31);
        voffA[i] = (unsigned)(R * g.lda + C) * 2u; voffB[i] = (unsigned)(Rb * g.ldb + C) * 2u; }
    const size_t kstep = (size_t)(BK * 2);
    const size_t hstepA = (size_t)HALF * g.lda * 2, hstepB = (size_t)HALF * g.ldb * 2;
    const unsigned ldsw = (unsigned)wid * 1024u;
    const int aoff = lds_byte(wr * 64 + fr, fq * 8), boff = lds_byte(wc * 32 + fr, fq * 8);
#define PG8_SA(b, h) (((b) * 2 + (h)) * HTB)
#define PG8_SB(b, h) ((4 + (b) * 2 + (h)) * HTB)
#define PG8_STAGE(bufoff, gbase, voff) do { _Pragma("unroll") for (int _i = 0; _i < 2; ++_i) \
        __builtin_amdgcn_global_load_lds((const unsigned*)((const char*)(gbase) + (voff)[_i]), (LAS unsigned*)(lds + (bufoff) + ldsw + _i * 8192), 16, 0, 0); } while (0)
#define PG8_LDA(dst, b, h) do { _Pragma("unroll") for (int m = 0; m < 4; ++m) _Pragma("unroll") for (int k = 0; k < 2; ++k) dst[m][k] = *(const LAS bf16x8*)(lds + PG8_SA(b, h) + aoff + m * 2048 + k * 1024); } while (0)
#define PG8_LDB(dst, b, h) do { _Pragma("unroll") for (int n = 0; n < 2; ++n) _Pragma("unroll") for (int k = 0; k < 2; ++k) dst[n][k] = *(const LAS bf16x8*)(lds + PG8_SB(b, h) + boff + n * 2048 + k * 1024); } while (0)
#define PG8_MMA(ai, bj, At, Bt) do { __builtin_amdgcn_s_setprio(1); _Pragma("unroll") for (int m = 0; m < 4; ++m) _Pragma("unroll") for (int n = 0; n < 2; ++n) _Pragma("unroll") for (int k = 0; k < 2; ++k) \
        acc[ai][bj][m][n] = __builtin_amdgcn_mfma_f32_16x16x32_bf16(Bt[n][k], At[m][k], acc[ai][bj][m][n], 0, 0, 0); __builtin_amdgcn_s_setprio(0); } while (0)
#define PG8_WAIT_V(n) asm volatile("s_waitcnt vmcnt(" #n ")" ::: "memory")
#define PG8_WAIT_L(n) asm volatile("s_waitcnt lgkmcnt(" #n ")" ::: "memory")
#define PG8_BAR __builtin_amdgcn_s_barrier()
#define PG8_SCHED __builtin_amdgcn_sched_barrier(0)
    Unit cur, nxt; int ui = 0;
    if (!S.next(0, cur)) return;
    f32x4 acc[2][2][4][2];
#pragma unroll
    for (int a = 0; a < 2; ++a)
#pragma unroll
        for (int b = 0; b < 2; ++b)
#pragma unroll
            for (int m = 0; m < 4; ++m)
#pragma unroll
                for (int n = 0; n < 2; ++n) acc[a][b][m][n] = (f32x4){0.f, 0.f, 0.f, 0.f};
    bf16x8 At[4][2], B0[2][2], B1[2][2];
    const char* cA = (const char*)g.A + cur.aoff; const char* cB = (const char*)g.Bt + cur.boff;
    PG8_STAGE(PG8_SB(0, 0), cB, voffB); PG8_STAGE(PG8_SA(0, 0), cA, voffA); PG8_STAGE(PG8_SB(0, 1), cB + hstepB, voffB); PG8_STAGE(PG8_SA(0, 1), cA + hstepA, voffA);
    if (wr == 1) PG8_BAR;
    PG8_WAIT_V(4); PG8_BAR;
    PG8_STAGE(PG8_SB(1, 0), cB + kstep, voffB); PG8_STAGE(PG8_SA(1, 0), cA + kstep, voffA); PG8_STAGE(PG8_SB(1, 1), cB + hstepB + kstep, voffB);
    PG8_WAIT_V(6); PG8_BAR;
    for (;;) {
        const bool has_next = S.next(ui + 1, nxt);
        const char* nA = has_next ? (const char*)g.A + nxt.aoff : cA; const char* nB = has_next ? (const char*)g.Bt + nxt.boff : cB;
        const int nt = SEG ? 24 : cur.nt;
        for (int t = 0; t < nt; t += 2) {
            const bool last = (t == nt - 2);
            const char *a1, *a2, *b2;
            if constexpr (SEG) { const int s1 = t >> 3, s2 = (t + 2) >> 3;
                a1 = cA + (size_t)(s1 > 0 ? 1 : 0) * (ar1 + (size_t)(s1 - 1) * ar2) + (size_t)((t & 7) + 1) * kstep;
                a2 = last ? nA : cA + (size_t)(s2 > 0 ? 1 : 0) * (ar1 + (size_t)(s2 - 1) * ar2) + (size_t)((t + 2) & 7) * kstep;
                b2 = last ? nB : cB + (size_t)s2 * brep + (size_t)((t + 2) & 7) * kstep;
                if constexpr (SEG) { if (t == 8 || t == 16) E.hook(acc, cur, t >> 3, wr, wc, fr, fq); }
            } else { a1 = cA + (size_t)(t + 1) * kstep; a2 = last ? nA : cA + (size_t)(t + 2) * kstep; b2 = last ? nB : cB + (size_t)(t + 2) * kstep; }
            const char* a3 = a2 + kstep; const char* b3 = b2 + kstep;
            PG8_LDB(B0, 0, 0); PG8_SCHED; PG8_LDA(At, 0, 0); PG8_STAGE(PG8_SA(1, 1), a1 + hstepA, voffA);
            PG8_WAIT_L(8); PG8_BAR; PG8_WAIT_L(0); PG8_MMA(0, 0, At, B0); PG8_BAR; PG8_SCHED;
            PG8_LDB(B1, 0, 1); PG8_STAGE(PG8_SB(0, 0), b2, voffB);
            PG8_BAR; PG8_WAIT_L(0); PG8_MMA(0, 1, At, B1); PG8_BAR;
            PG8_LDA(At, 0, 1); PG8_STAGE(PG8_SA(0, 0), a2, voffA);
            PG8_BAR; PG8_WAIT_L(0); PG8_MMA(1, 0, At, B0); PG8_BAR; PG8_SCHED;
            PG8_STAGE(PG8_SB(0, 1), b2 + hstepB, voffB);
            PG8_WAIT_V(6); PG8_BAR; PG8_MMA(1, 1, At, B1); PG8_BAR;
            PG8_LDB(B0, 1, 0); PG8_SCHED; PG8_LDA(At, 1, 0); PG8_STAGE(PG8_SA(0, 1), a2 + hstepA, voffA);
            PG8_WAIT_L(8); PG8_BAR; PG8_WAIT_L(0); PG8_MMA(0, 0, At, B0); PG8_BAR; PG8_SCHED;
            PG8_LDB(B1, 1, 1); PG8_STAGE(PG8_SB(1, 0), b3, voffB);
            PG8_BAR; PG8_WAIT_L(0); PG8_MMA(0, 1, At, B1); PG8_BAR;
            PG8_LDA(At, 1, 1); PG8_STAGE(PG8_SA(1, 0), a3, voffA);
            PG8_BAR; PG8_WAIT_L(0); PG8_MMA(1, 0, At, B0); PG8_BAR; PG8_SCHED;
            PG8_STAGE(PG8_SB(1, 1), b3 + hstepB, voffB);
            PG8_WAIT_V(6); PG8_BAR; PG8_MMA(1, 1, At, B1); PG8_BAR;
        }
        E(acc, cur, wr, wc, fr, fq);
        if (!has_next) break;
#pragma unroll
        for (int a = 0; a < 2; ++a)
#pragma unroll
            for (int b = 0; b < 2; ++b)
#pragma unroll
                for (int m = 0; m < 4; ++m)
#pragma unroll
                    for (int n = 0; n < 2; ++n) acc[a][b][m][n] = (f32x4){0.f, 0.f, 0.f, 0.f};
        cur = nxt; cA = nA; cB = nB; ++ui;
    }
    PG8_WAIT_V(0);
    if (wr == 0) PG8_BAR;
    PG8_BAR;
#undef PG8_SA
#undef PG8_SB
#undef PG8_STAGE
#undef PG8_LDA
#undef PG8_LDB
#undef PG8_MMA
#undef PG8_WAIT_V
#undef PG8_WAIT_L
#undef PG8_BAR
#undef PG8_SCHED
}
}

__device__ __forceinline__ void conv_tile(float* lf, const float* __restrict__ src, int ld, bf16_t* dst, int K, int tv, int tk4, int map) {
    const int tid = opaque_tid();
    { const int vq = tid & 15, kr = tid >> 4; const int v = tv * 64 + vq * 4;
      int sc = v;
      if (map == 1) sc = (((v >> 7) & 1) ? DFF : 0) + (v >> 8) * 128 + (v & 127);
      else if (map == 2 && v < QKVC) {
          const int tl = v >> 8, vv = v & 255, bj = vv >> 7, o = vv & 127, wcv = o >> 5, ii = o & 31;
          if (tl == 2 || tl == 3 || tl == 7) sc = tl * 256 + wcv * 64 + bj * 32 + ii;
          else if (tl == 14) sc = wcv < 2 ? 3584 + wcv * 64 + bj * 32 + ii : 3712 + bj * 64 + (wcv - 2) * 32 + ii; }
      else if (map == 2 && v >= QKVC) { const int vv = v - QKVC, o = vv & 127;
          sc = QKVC + (vv >> 8) * 256 + (o >> 5) * 64 + ((o >> 3) & 3) * 16 + ((vv >> 7) & 1) * 8 + (o & 7); }
      const float* sp = src + (size_t)(tk4 * 256 + kr) * ld + sc;
      f32x4 x[8];
#pragma unroll
      for (int j = 0; j < 8; ++j) x[j] = *(const f32x4*)(sp + (size_t)(j * 32) * ld);
#pragma unroll
      for (int j = 0; j < 8; ++j) { float* lp = lf + (j * 32 + kr) * 65 + vq * 4; lp[0] = x[j][0]; lp[1] = x[j][1]; lp[2] = x[j][2]; lp[3] = x[j][3]; } }
    __syncthreads();
    { const int lane = tid & 63, w = tid >> 6;
#pragma unroll
      for (int jj = 0; jj < 4; ++jj) { const int task = w + jj * 8; const int v = (task & 7) * 8 + (lane & 7), k0 = ((task >> 3) * 8 + (lane >> 3)) * 8;
          float f[8];
#pragma unroll
          for (int e = 0; e < 8; ++e) f[e] = lf[(k0 + e) * 65 + v];
          u32x4 wv; wv.x = pk_bf16(f[0], f[1]); wv.y = pk_bf16(f[2], f[3]); wv.z = pk_bf16(f[4], f[5]); wv.w = pk_bf16(f[6], f[7]);
          *(u32x4*)(dst + (size_t)(tv * 64 + v) * K + tk4 * 256 + k0) = wv; } }
    __syncthreads();
}
constexpr int CONV_FFN_TILES = 352 + 176, CONV_MIX_TILES = 432 + 96 + 64;
__device__ __forceinline__ void conv_ffn(const Params& p, float* lf, int l, int which, int it) {
    if (it < 352) conv_tile(lf, p.w_ffn_in + (size_t)(l * 2 + which) * DM * 2 * DFF, 2 * DFF, (bf16_t*)(p.ws + WS_WFI), DM, it >> 2, it & 3, 1);
    else { it -= 352; conv_tile(lf, p.w_ffn_out + (size_t)(l * 2 + which) * DFF * DM, DM, (bf16_t*)(p.ws + WS_WFO), DFF, it / 11, it % 11, 0); }
}
__device__ __forceinline__ void conv_mix(const Params& p, float* lf, int l, int it) {
    if (it < 432) conv_tile(lf, p.w_in + (size_t)l * DM * INC, INC, (bf16_t*)(p.ws + WS_WMI), DM, it >> 2, it & 3, 2);
    else if (it < 432 + 96) { const int j = it - 432, br = j >> 5, jj = j & 31;
        conv_tile(lf, p.w_branch + (size_t)(l * 3 + br) * 512 * DM, DM, (bf16_t*)(p.ws + WS_WMB) + (size_t)br * DM * 512, 512, jj >> 1, jj & 1, 0); }
    else { const int j = it - 528; conv_tile(lf, p.w_out + (size_t)l * DM * DM, DM, (bf16_t*)(p.ws + WS_WMO), DM, j >> 2, j & 3, 0); }
}

__device__ __forceinline__ void conv_tail(const Params& p, unsigned char* lds, int cw, int total, int mix, int l, int which) {
    unsigned* ctr = (unsigned*)(p.ws + WS_BAR) + 3600 + cw;
    volatile LAS unsigned* slot = (volatile LAS unsigned*)((LAS unsigned char*)lds + LDS_MAIN) + 2;
    float* lf = (float*)lds;
    for (;;) {
        if (threadIdx.x == 0) slot[0] = atomicAdd(ctr, 1u);
        __syncthreads();
        const int it = (int)slot[0];
        __syncthreads();
        if (it >= total) break;
        if (mix) conv_mix(p, lf, l, it); else conv_ffn(p, lf, l, which, it);
    }
}

__device__ __forceinline__ void mod_item(const Params& p, float* lf, int it) {
    float* sl = lf;
    float* red = lf + 1024 * 20;
    const int tid = opaque_tid(), lane = tid & 63, w = tid >> 6;
    const int l = it / 144, col0 = (it % 144) * 64;
    for (int idx = tid; idx < 17 * 1024; idx += NTHREADS) { const int r = idx >> 10, k = idx & 1023; const float v = r < 16 ? p.c[r * 1024 + k] : p.c_ctx[k]; sl[k * 20 + r] = v / (1.0f + __expf(-v)); }
    __syncthreads();
    float acc[17];
#pragma unroll
    for (int r = 0; r < 17; ++r) acc[r] = 0.f;
    const float* wp = p.w_mod + ((size_t)l * DM + w * 128) * MODC + col0 + lane;
#pragma unroll 8
    for (int k = 0; k < 128; ++k) {
        const float wv = wp[(size_t)k * MODC];
        const float* sp = sl + (w * 128 + k) * 20;
        const f32x4 s0 = *(const f32x4*)(sp), s1 = *(const f32x4*)(sp + 4), s2 = *(const f32x4*)(sp + 8), s3 = *(const f32x4*)(sp + 12); const float s4 = sp[16];
        acc[0] += s0[0] * wv; acc[1] += s0[1] * wv; acc[2] += s0[2] * wv; acc[3] += s0[3] * wv;
        acc[4] += s1[0] * wv; acc[5] += s1[1] * wv; acc[6] += s1[2] * wv; acc[7] += s1[3] * wv;
        acc[8] += s2[0] * wv; acc[9] += s2[1] * wv; acc[10] += s2[2] * wv; acc[11] += s2[3] * wv;
        acc[12] += s3[0] * wv; acc[13] += s3[1] * wv; acc[14] += s3[2] * wv; acc[15] += s3[3] * wv; acc[16] += s4 * wv;
    }
#pragma unroll
    for (int r = 0; r < 17; ++r) red[(w * 17 + r) * 64 + lane] = acc[r];
    __syncthreads();
    float* mod = (float*)(p.ws + WS_MOD);
    for (int o = tid; o < 17 * 64; o += NTHREADS) { const int r = o >> 6, ln = o & 63; float s = p.b_mod[l * MODC + col0 + ln];
#pragma unroll
        for (int ww = 0; ww < 8; ++ww) s += red[(ww * 17 + r) * 64 + ln];
        mod[((size_t)l * 17 + r) * MODC + col0 + ln] = s; }
    __syncthreads();
}
__device__ __forceinline__ void misc_item(const Params& p) {
    const int tid = opaque_tid();
    f32x2* rope = (f32x2*)(p.ws + WS_ROPE);
    for (int e = tid; e < 1024; e += NTHREADS) { const int pos = e >> 4, f = e & 15;
        const float inv = powf(10000.0f, -(float)f / 16.0f); const float ang = (float)pos * inv;
        double a = (double)ang * 0.15915494309189535; a -= floor(a); const float fr = (float)a;
        rope[e] = (f32x2){__builtin_amdgcn_cosf(fr), __builtin_amdgcn_sinf(fr)}; }
    float* misc = (float*)(p.ws + WS_MISC);
    if (tid < DEPTH) { const int l = tid; const float* dl = p.diff_lambda + l * 256; float s1 = 0.f, s2 = 0.f;
        for (int i = 0; i < 64; ++i) { s1 += dl[i] * dl[64 + i]; s2 += dl[128 + i] * dl[192 + i]; }
        const float lam_init = 0.8f - 0.6f * expf(-0.3f * (float)l);
        misc[l * 16 + 0] = expf(s1) - expf(s2) + lam_init; misc[l * 16 + 1] = lam_init; }
    if (tid >= 64 && tid < 64 + DEPTH * 8) { const int j = tid - 64, l = j >> 3, dh = j & 7;
        const float x = p.ret_logit[l * 8 + dh]; misc[l * 16 + 4 + dh] = -log1pf(expf(-x)) * 1.4426950408889634f; }
}

struct ERow { f32x4 h[4]; u32x2 y[4]; };
__device__ __forceinline__ void erow_load(ERow& r, const Params& p, bool first, bool from_input, const bf16_t* ysrc, bool ysplit, int t, int lane) {
    const int b = t / TPB, n = t - b * TPB; const bool isctx = n >= SEQ;
    const float* hsrc = from_input ? (isctx ? p.ctx + (size_t)(b * CTXL + n - SEQ) * DM : p.x + (size_t)(b * SEQ + n) * DM)
                              : (isctx ? (const float*)(p.ws + WS_HC) + (size_t)(b * CTXL + n - SEQ) * DM : p.out + (size_t)(b * SEQ + n) * DM);
#pragma unroll
    for (int i = 0; i < 4; ++i) r.h[i] = __builtin_nontemporal_load((const f32x4*)(hsrc + i * 256 + lane * 4));
    if (!first) {
        const bf16_t* yp = (ysplit && isctx) ? (const bf16_t*)(p.ws + WS_PART) + (size_t)(b * CTXL + n - SEQ) * DM : ysrc + (size_t)t * DM;
#pragma unroll
        for (int i = 0; i < 4; ++i) r.y[i] = *(const u32x2*)(yp + i * 256 + lane * 4);
    }
}
__device__ __forceinline__ void ephase_rows(const Params& p, bool first, bool from_input, int lp, int sp, float gs, const bf16_t* ysrc, bool ysplit, int ln, int sn, bool latent_only, int dummy) {
    const int tid = opaque_tid(); const int lane = tid & 63, w = tid >> 6;
    const float* mod = (const float*)(p.ws + WS_MOD);
    float* hc = (float*)(p.ws + WS_HC);
    bf16_t* Y = (bf16_t*)(p.ws + WS_Y);
    const int nrows = latent_only ? NB * SEQ : NT, stride = gridDim.x * 8;
    int i = blockIdx.x * 8 + w;
    if (i >= nrows) return;
    ERow cur, nxt;
    int t = latent_only ? (i >> 11) * TPB + (i & 2047) : i;
    erow_load(cur, p, first, from_input, ysrc, ysplit, t, lane);
    for (;;) {
        const int in = i + stride; const bool has_next = in < nrows;
        const int tn = latent_only ? (in >> 11) * TPB + (in & 2047) : in;
        if (has_next) erow_load(nxt, p, first, from_input, ysrc, ysplit, tn, lane);
        const int b = t / TPB, n = t - b * TPB; const bool isctx = n >= SEQ;
        float* hp = isctx ? hc + (size_t)(b * CTXL + n - SEQ) * DM : p.out + (size_t)(b * SEQ + n) * DM;
        const int mrow = isctx ? 16 : b;
        f32x4 h[4];
#pragma unroll
        for (int k = 0; k < 4; ++k) h[k] = cur.h[k];
        if (!first) {
            const float* mp = mod + ((size_t)lp * 17 + mrow) * MODC + sp * 3072 + 2048;
            const float* gpost = p.norm_g + (size_t)(lp * 6 + 2 * sp + 1) * DM;
            f32x4 y[4]; float ss = 0.f;
#pragma unroll
            for (int k = 0; k < 4; ++k) { const u32x2 v = cur.y[k]; y[k] = (f32x4){bf_lo(v.x), bf_hi(v.x), bf_lo(v.y), bf_hi(v.y)}; }
            if (ysplit && isctx) {
                const bf16_t* pp = (const bf16_t*)(p.ws + WS_PART) + (size_t)(b * CTXL + n - SEQ) * DM + lane * 4;
#pragma unroll
                for (int q = 1; q < 4; ++q)
#pragma unroll
                    for (int k = 0; k < 4; ++k) { const u32x2 v = *(const u32x2*)(pp + (size_t)q * (NB * CTXL) * DM + k * 256); y[k] += (f32x4){bf_lo(v.x), bf_hi(v.x), bf_lo(v.y), bf_hi(v.y)}; }
            }
#pragma unroll
            for (int k = 0; k < 4; ++k) ss += y[k][0] * y[k][0] + y[k][1] * y[k][1] + y[k][2] * y[k][2] + y[k][3] * y[k][3];
            ss = wave_sum(ss); const float r = rsqrtf(ss * (1.0f / DM) + EPS);
#pragma unroll
            for (int k = 0; k < 4; ++k) { const f32x4 ga = *(const f32x4*)(mp + k * 256 + lane * 4), gp = *(const f32x4*)(gpost + k * 256 + lane * 4);
                h[k] += gs * ga * (y[k] * r * gp); }
        }
#pragma unroll
        for (int k = 0; k < 4; ++k) if (!dummy && !first) __builtin_nontemporal_store(h[k], (f32x4*)(hp + k * 256 + lane * 4));
        if (sn >= 0) {
            float ss = 0.f;
#pragma unroll
            for (int k = 0; k < 4; ++k) ss += h[k][0] * h[k][0] + h[k][1] * h[k][1] + h[k][2] * h[k][2] + h[k][3] * h[k][3];
            ss = wave_sum(ss); const float r = rsqrtf(ss * (1.0f / DM) + EPS);
            const float* mp = mod + ((size_t)ln * 17 + mrow) * MODC + sn * 3072;
            const float* gpre = p.norm_g + (size_t)(ln * 6 + 2 * sn) * DM;
#pragma unroll
            for (int k = 0; k < 4; ++k) { const f32x4 sh = *(const f32x4*)(mp + k * 256 + lane * 4), sc = *(const f32x4*)(mp + 1024 + k * 256 + lane * 4), gp = *(const f32x4*)(gpre + k * 256 + lane * 4);
                const f32x4 o = h[k] * r * gp * (1.0f + sc) + sh;
                u32x2 wv; wv.x = pk_bf16(o[0], o[1]); wv.y = pk_bf16(o[2], o[3]);
                if (!dummy) *(u32x2*)(Y + (size_t)t * DM + k * 256 + lane * 4) = wv; }
        }
        if (!has_next) break;
        cur = nxt; i = in; t = tn;
    }
}

__device__ __forceinline__ void rope_phase(const Params& p, int l, int dummy) {
    bf16_t* P = (bf16_t*)(p.ws + WS_P);
    const f32x2* rope = (const f32x2*)(p.ws + WS_ROPE);
    const long total = (long)NT * 56;
    const int tid = opaque_tid();
    for (long idx = (long)blockIdx.x * NTHREADS + tid; idx < total; idx += (long)gridDim.x * NTHREADS) {
        const int t = (int)(idx / 56), rem = (int)(idx - (long)t * 56), gi = rem >> 2, j = rem & 3;
        const int n = t % TPB; const bool isctx = n >= SEQ;
        const bool cnorm = gi >= 12;
        if (isctx && !cnorm) continue;
        const int col = gi < 8 ? 512 + gi * 64 : (gi < 12 ? 1792 + (gi - 8) * 64 : 3584 + (gi - 12) * 64);
        bf16_t* bp = P + (size_t)t * QKVC + col + j * 8;
        const u32x4 r1 = *(const u32x4*)bp, r2 = *(const u32x4*)(bp + 32);
        float x1[8] = {bf_lo(r1.x), bf_hi(r1.x), bf_lo(r1.y), bf_hi(r1.y), bf_lo(r1.z), bf_hi(r1.z), bf_lo(r1.w), bf_hi(r1.w)};
        float x2[8] = {bf_lo(r2.x), bf_hi(r2.x), bf_lo(r2.y), bf_hi(r2.y), bf_lo(r2.z), bf_hi(r2.z), bf_lo(r2.w), bf_hi(r2.w)};
        if (cnorm) {
            float ss = 0.f;
#pragma unroll
            for (int e = 0; e < 8; ++e) ss += x1[e] * x1[e] + x2[e] * x2[e];
            ss += __shfl_xor(ss, 1); ss += __shfl_xor(ss, 2);
            const float r = rsqrtf(ss * (1.0f / 64.0f) + EPS);
            const float* g = p.qk_norm_g + (size_t)(l * 2 + 1) * 64 + j * 8;
#pragma unroll
            for (int e = 0; e < 8; ++e) { x1[e] *= r * g[e]; x2[e] *= r * g[32 + e]; }
        }
        if (!isctx) {
            const int pos = (j < 2) ? (n >> 6) : (n & 63);
            const f32x2* cs = rope + pos * 16 + (j & 1) * 8;
#pragma unroll
            for (int e = 0; e < 8; ++e) { const f32x2 v = cs[e]; const float a = x1[e], bq = x2[e]; x1[e] = a * v.x - bq * v.y; x2[e] = a * v.y + bq * v.x; }
        }
        if (!dummy) {
            u32x4 w1, w2;
            w1.x = pk_bf16(x1[0], x1[1]); w1.y = pk_bf16(x1[2], x1[3]); w1.z = pk_bf16(x1[4], x1[5]); w1.w = pk_bf16(x1[6], x1[7]);
            w2.x = pk_bf16(x2[0], x2[1]); w2.y = pk_bf16(x2[2], x2[3]); w2.z = pk_bf16(x2[4], x2[5]); w2.w = pk_bf16(x2[6], x2[7]);
            *(u32x4*)bp = w1; *(u32x4*)(bp + 32) = w2;
        }
    }
}

__device__ __forceinline__ void rs1_task(const Params& p, unsigned char* lds, int l, int task) {
    constexpr int KST = 160, VST = 288, KB = 64 * KST, VB = 64 * VST;
    const int tid = opaque_tid(), lane = tid & 63, w = __builtin_amdgcn_readfirstlane(tid >> 6), lq = lane & 15, g = lane >> 4;
    const int blk = task % 9, bh = task / 9, h = bh & 3, b = bh >> 2;
    const bf16_t* P = (const bf16_t*)(p.ws + WS_P);
    const float* misc = (const float*)(p.ws + WS_MISC) + l * 16;
    const float lf2 = misc[4 + h], lb2 = misc[8 + h];
    const size_t row0 = (size_t)b * TPB + (blk < 8 ? blk * 256 : SEQ);
    const int kcol = 1792 + h * 64, vcol = 2048 + h * 128;
    const unsigned lds_base = (unsigned)(uintptr_t)(LAS unsigned char*)lds;
    const unsigned kaddr = lds_base + (4 * g + (lq >> 2)) * KST + (lq & 3) * 8;
    const unsigned vaddr = lds_base + KB + (4 * g + (lq >> 2)) * VST + (lq & 3) * 8 + w * 32;
    f32x4 Uf[4], Ub[4];
#pragma unroll
    for (int i = 0; i < 4; ++i) { Uf[i] = (f32x4){0.f, 0.f, 0.f, 0.f}; Ub[i] = (f32x4){0.f, 0.f, 0.f, 0.f}; }
    for (int tt = 0; tt < 4; ++tt) {
        { const size_t r0 = row0 + (size_t)tt * 64;
          const int kr = tid >> 3, kc = tid & 7;
          const u32x4 kv = *(const u32x4*)(P + (r0 + kr) * QKVC + kcol + kc * 8);
          u32x4 vv[2];
#pragma unroll
          for (int i = 0; i < 2; ++i) { const int id = tid + i * NTHREADS; vv[i] = *(const u32x4*)(P + (r0 + (id >> 4)) * QKVC + vcol + (id & 15) * 8); }
          *(u32x4*)(lds + kr * KST + kc * 16) = kv;
#pragma unroll
          for (int i = 0; i < 2; ++i) { const int id = tid + i * NTHREADS; *(u32x4*)(lds + KB + (id >> 4) * VST + (id & 15) * 16) = vv[i]; } }
        __syncthreads();
#pragma unroll
        for (int st = 0; st < 2; ++st) {
            s16x4 v0, v1;
            asm volatile("ds_read_b64_tr_b16 %0, %2 offset:%3\n\tds_read_b64_tr_b16 %1, %2 offset:%4\n\ts_waitcnt lgkmcnt(0)" : "=&v"(v0), "=&v"(v1) : "v"(vaddr), "i"(st * 32 * VST), "i"(st * 32 * VST + 16 * VST) : "memory");
            const u32x2 a0 = __builtin_bit_cast(u32x2, v0), a1 = __builtin_bit_cast(u32x2, v1);
            float x[8] = {bf_lo(a0.x), bf_hi(a0.x), bf_lo(a0.y), bf_hi(a0.y), bf_lo(a1.x), bf_hi(a1.x), bf_lo(a1.y), bf_hi(a1.y)};
            float xf[8], xb[8];
#pragma unroll
            for (int e = 0; e < 8; ++e) { const int jj = tt * 64 + st * 32 + (e < 4 ? 4 * g + e : 16 + 4 * g + (e - 4));
                xf[e] = x[e] * __builtin_amdgcn_exp2f(lf2 * (float)(255 - jj)); xb[e] = x[e] * __builtin_amdgcn_exp2f(lb2 * (float)jj); }
            u32x4 pf_, pb_;
            pf_.x = pk_bf16(xf[0], xf[1]); pf_.y = pk_bf16(xf[2], xf[3]); pf_.z = pk_bf16(xf[4], xf[5]); pf_.w = pk_bf16(xf[6], xf[7]);
            pb_.x = pk_bf16(xb[0], xb[1]); pb_.y = pk_bf16(xb[2], xb[3]); pb_.z = pk_bf16(xb[4], xb[5]); pb_.w = pk_bf16(xb[6], xb[7]);
            const bf16x8 vf = __builtin_bit_cast(bf16x8, pf_), vb = __builtin_bit_cast(bf16x8, pb_);
#pragma unroll
            for (int dk = 0; dk < 4; ++dk) {
                s16x4 k0, k1;
                asm volatile("ds_read_b64_tr_b16 %0, %2 offset:%3\n\tds_read_b64_tr_b16 %1, %2 offset:%4\n\ts_waitcnt lgkmcnt(0)" : "=&v"(k0), "=&v"(k1) : "v"(kaddr), "i"(st * 32 * KST + dk * 32), "i"(st * 32 * KST + 16 * KST + dk * 32) : "memory");
                const bf16x8 kf = __builtin_shufflevector(k0, k1, 0, 1, 2, 3, 4, 5, 6, 7);
                Uf[dk] = __builtin_amdgcn_mfma_f32_16x16x32_bf16(vf, kf, Uf[dk], 0, 0, 0);
                Ub[dk] = __builtin_amdgcn_mfma_f32_16x16x32_bf16(vb, kf, Ub[dk], 0, 0, 0);
            }
        }
        __syncthreads();
    }
    float* U = (float*)(p.ws + WS_RSU) + ((size_t)(bh * 9 + blk) * 2) * 8192;
#pragma unroll
    for (int dk = 0; dk < 4; ++dk)
#pragma unroll
        for (int r = 0; r < 4; ++r) { const int o = (16 * w + 4 * g + r) * 64 + 16 * dk + lq; U[o] = Uf[dk][r]; U[8192 + o] = Ub[dk][r]; }
}
__device__ __forceinline__ void rs1_phase(const Params& p, unsigned char* lds, int l) {
    const int G = (int)gridDim.x, bx = (int)blockIdx.x;
    const int vcu = (G % 8 == 0) ? (bx % 8) * (G / 8) + bx / 8 : bx;
    for (int task = vcu; task < NB * 4 * 9; task += G) rs1_task(p, lds, l, task);
}
__device__ __forceinline__ void rs2_phase(const Params& p, int l) {
    const int tid = opaque_tid();
    const float* misc = (const float*)(p.ws + WS_MISC) + l * 16;
    for (int task = blockIdx.x; task < NB * 4 * 2; task += gridDim.x) {
        const int dir = task & 1, bh = task >> 1, h = bh & 3;
        const float g256 = __builtin_amdgcn_exp2f(256.0f * misc[4 + dir * 4 + h]);
        const float* U = (const float*)(p.ws + WS_RSU) + (size_t)bh * 9 * 2 * 8192 + dir * 8192;
        bf16_t* ST = (bf16_t*)(p.ws + WS_RST) + (size_t)bh * 8 * 2 * 8192 + dir * 8192;
        f32x4 s[4];
#pragma unroll
        for (int j = 0; j < 4; ++j) s[j] = *(const f32x4*)(U + (size_t)8 * 16384 + (tid + j * NTHREADS) * 4);
        for (int step = 0; step < 8; ++step) {
            const int i = dir ? 7 - step : step;
#pragma unroll
            for (int j = 0; j < 4; ++j) { u32x2 wv; wv.x = pk_bf16(s[j][0], s[j][1]); wv.y = pk_bf16(s[j][2], s[j][3]); *(u32x2*)(ST + (size_t)i * 16384 + (tid + j * NTHREADS) * 4) = wv;
                const f32x4 u = *(const f32x4*)(U + (size_t)i * 16384 + (tid + j * NTHREADS) * 4); s[j] = s[j] * g256 + u; }
        }
    }
}

template <int KIND>
__device__ __forceinline__ void attn_item(unsigned char* lds, bf16_t* P, const Params& p, int l, int b, int head, int qb, int isctx, int dummy) {
    constexpr int KW = (KIND == 0) ? 128 : 64, DV = (KIND == 2) ? 64 : 128, NDB = DV / 16;
    constexpr int KSTR = KW * 2, VSTR = DV * 2 + 32, KBYTES = 64 * KSTR, VBYTES = 64 * VSTR;
#define ATT_KSW(row) ((KW == 64) ? (((row) >> 1) & 7) : ((row) & 15))
    constexpr int KCH = KW / 64, VCH = DV / 64;
    const int tid = opaque_tid(), lane = tid & 63, w = tid >> 6, lq = lane & 15, g = lane >> 4;
    const float* misc = (const float*)(p.ws + WS_MISC) + l * 16;
    const int comp = (KIND == 0) ? (w >> 2) : 0;
    const int qn0 = (KIND == 0) ? qb * 128 + (w & 3) * 32 : qb * 256 + w * 32;
    const size_t rowbase = (size_t)b * TPB + (isctx ? SEQ : 0);
    const int qcol = (KIND == 0) ? head * 128 + comp * 64 : (KIND == 1) ? 1536 + head * 64 : 3072 + head * 64;
    const int kcol = (KIND == 0) ? 512 + head * 128 : (KIND == 1) ? 1792 + head * 64 : 3584 + (head >> 2) * 64;
    const int vcol = (KIND == 0) ? 1024 + head * 128 : (KIND == 1) ? 2048 + head * 128 : 3712 + (head >> 2) * 64;
    const int kt0 = isctx ? 32 : (KIND == 1 ? 4 * qb : 0), nkt = (isctx || KIND == 1) ? 4 : 36;
    const size_t keyrow0 = (size_t)b * TPB + (size_t)kt0 * 64;

    bf16x8 qf[2][2];
#pragma unroll
    for (int qs = 0; qs < 2; ++qs)
#pragma unroll
        for (int ks = 0; ks < 2; ++ks) qf[qs][ks] = *(const bf16x8*)(P + (rowbase + qn0 + qs * 16 + lq) * QKVC + qcol + ks * 32 + g * 8);
    {
        const f32x2* rope = (const f32x2*)(p.ws + WS_ROPE);
        const float qscale = (KIND == 1) ? 0.125f : 0.125f * 1.4426950408889634f;
#pragma unroll
        for (int qs = 0; qs < 2; ++qs) {
            const u32x4 r1 = __builtin_bit_cast(u32x4, qf[qs][0]), r2 = __builtin_bit_cast(u32x4, qf[qs][1]);
            float x1[8] = {bf_lo(r1.x), bf_hi(r1.x), bf_lo(r1.y), bf_hi(r1.y), bf_lo(r1.z), bf_hi(r1.z), bf_lo(r1.w), bf_hi(r1.w)};
            float x2[8] = {bf_lo(r2.x), bf_hi(r2.x), bf_lo(r2.y), bf_hi(r2.y), bf_lo(r2.z), bf_hi(r2.z), bf_lo(r2.w), bf_hi(r2.w)};
            if (KIND == 2) {
                float ss = 0.f;
#pragma unroll
                for (int e = 0; e < 8; ++e) ss += x1[e] * x1[e] + x2[e] * x2[e];
                ss += __shfl_xor(ss, 16); ss += __shfl_xor(ss, 32);
                const float rn = rsqrtf(ss * (1.0f / 64.0f) + EPS);
                const float* gq = p.qk_norm_g + (size_t)(l * 2) * 64 + g * 8;
#pragma unroll
                for (int e = 0; e < 8; ++e) { x1[e] *= rn * gq[e]; x2[e] *= rn * gq[32 + e]; }
            }
            if (!isctx) {
                const int n = qn0 + qs * 16 + lq;
                const int pos = (g < 2) ? (n >> 6) : (n & 63);
                const f32x2* cs = rope + pos * 16 + (g & 1) * 8;
#pragma unroll
                for (int e = 0; e < 8; ++e) { const f32x2 v = cs[e]; const float a = x1[e], bq = x2[e]; x1[e] = a * v.x - bq * v.y; x2[e] = a * v.y + bq * v.x; }
            }
#pragma unroll
            for (int e = 0; e < 8; ++e) { x1[e] *= qscale; x2[e] *= qscale; }
            u32x4 w1, w2;
            w1.x = pk_bf16(x1[0], x1[1]); w1.y = pk_bf16(x1[2], x1[3]); w1.z = pk_bf16(x1[4], x1[5]); w1.w = pk_bf16(x1[6], x1[7]);
            w2.x = pk_bf16(x2[0], x2[1]); w2.y = pk_bf16(x2[2], x2[3]); w2.z = pk_bf16(x2[4], x2[5]); w2.w = pk_bf16(x2[6], x2[7]);
            qf[qs][0] = __builtin_bit_cast(bf16x8, w1); qf[qs][1] = __builtin_bit_cast(bf16x8, w2);
        }
    }

    float lf2 = 0.f, lb2 = 0.f;
    if (KIND == 1) { lf2 = misc[4 + head]; lb2 = misc[8 + head]; }

    f32x4 O[NDB][2];
    float mrun[2];
    f32x4 Ol[2];
    const bf16x8 ones = (bf16x8){16256, 16256, 16256, 16256, 16256, 16256, 16256, 16256};

    u32x4 kreg[2][KCH], vreg[2][VCH];
    int krow[KCH], kcc[KCH], vrow[VCH], vcc[VCH];
#pragma unroll
    for (int i = 0; i < KCH; ++i) { const int id = tid + i * NTHREADS; krow[i] = id / (KW / 8); kcc[i] = id % (KW / 8); }
#pragma unroll
    for (int i = 0; i < VCH; ++i) { const int id = tid + i * NTHREADS; vrow[i] = id / (DV / 8); vcc[i] = id % (DV / 8); }
#define ATT_LOAD(t, set) do { const size_t r0 = keyrow0 + (size_t)(t) * 64; \
        _Pragma("unroll") for (int i = 0; i < KCH; ++i) kreg[set][i] = *(const u32x4*)(P + (r0 + krow[i]) * QKVC + kcol + kcc[i] * 8); \
        _Pragma("unroll") for (int i = 0; i < VCH; ++i) vreg[set][i] = *(const u32x4*)(P + (r0 + vrow[i]) * QKVC + vcol + vcc[i] * 8); } while (0)
#define ATT_STORE(buf, vbuf, set) do { unsigned char* kb_ = lds + (buf) * KBYTES; unsigned char* vb_ = lds + 2 * KBYTES + (vbuf) * VBYTES; \
        _Pragma("unroll") for (int i = 0; i < KCH; ++i) *(u32x4*)(kb_ + krow[i] * KSTR + ((kcc[i] ^ ATT_KSW(krow[i])) * 16)) = kreg[set][i]; \
        _Pragma("unroll") for (int i = 0; i < VCH; ++i) *(u32x4*)(vb_ + vrow[i] * VSTR + vcc[i] * 16) = vreg[set][i]; } while (0)

    const unsigned lds_base = (unsigned)(uintptr_t)(LAS unsigned char*)lds;
    const float csc = 0.125f * 1.4426950408889634f;
    float dfa0 = 0.f, dba0 = 0.f, f16 = 0.f, b16 = 0.f, dfr[4] = {1.f, 1.f, 1.f, 1.f}, dbr[4] = {1.f, 1.f, 1.f, 1.f};
    if (KIND == 1) {
        dfa0 = __builtin_amdgcn_exp2f(-lf2 * (float)(4 * g)); dba0 = __builtin_amdgcn_exp2f(lb2 * (float)(4 * g));
        f16 = __builtin_amdgcn_exp2f(-lf2 * 16.0f); b16 = __builtin_amdgcn_exp2f(lb2 * 16.0f);
#pragma unroll
        for (int i = 1; i < 4; ++i) { dfr[i] = __builtin_amdgcn_exp2f(-lf2 * (float)i); dbr[i] = __builtin_amdgcn_exp2f(lb2 * (float)i); }
    }
#define ATT_TR(dst, db) asm volatile("ds_read_b64_tr_b16 %0, %4 offset:%5\n\tds_read_b64_tr_b16 %1, %4 offset:%6\n\tds_read_b64_tr_b16 %2, %4 offset:%7\n\tds_read_b64_tr_b16 %3, %4 offset:%8" \
                         : "=&v"(dst[0]), "=&v"(dst[1]), "=&v"(dst[2]), "=&v"(dst[3]) \
                         : "v"(vaddr), "i"((db) * 32), "i"((db) * 32 + 16 * VSTR), "i"((db) * 32 + 32 * VSTR), "i"((db) * 32 + 48 * VSTR) : "memory")
#define ATT_PV(vb) do { const unsigned vaddr = vaddr0 + (unsigned)(vb) * VBYTES; s16x4 vr[2][4]; ATT_TR(vr[0], 0); \
        _Pragma("unroll") for (int db = 0; db < NDB; ++db) { \
            if (db + 1 < NDB) { ATT_TR(vr[(db + 1) & 1], db + 1); \
                asm volatile("s_waitcnt lgkmcnt(4)" : "+v"(vr[db & 1][0]), "+v"(vr[db & 1][1]), "+v"(vr[db & 1][2]), "+v"(vr[db & 1][3]) :: "memory"); } \
            else asm volatile("s_waitcnt lgkmcnt(0)" : "+v"(vr[db & 1][0]), "+v"(vr[db & 1][1]), "+v"(vr[db & 1][2]), "+v"(vr[db & 1][3]) :: "memory"); \
            const bf16x8 vf0 = __builtin_shufflevector(vr[db & 1][0], vr[db & 1][1], 0, 1, 2, 3, 4, 5, 6, 7); \
            const bf16x8 vf1 = __builtin_shufflevector(vr[db & 1][2], vr[db & 1][3], 0, 1, 2, 3, 4, 5, 6, 7); \
            __builtin_amdgcn_s_setprio(1); \
            _Pragma("unroll") for (int qs = 0; qs < 2; ++qs) { \
                O[db][qs] = __builtin_amdgcn_mfma_f32_16x16x32_bf16(vf0, pf[qs][0], O[db][qs], 0, 0, 0); \
                O[db][qs] = __builtin_amdgcn_mfma_f32_16x16x32_bf16(vf1, pf[qs][1], O[db][qs], 0, 0, 0); } \
            __builtin_amdgcn_s_setprio(0); } } while (0)
    const bool skew = ATT_SKEW && (w >= 4);
    const unsigned vaddr0 = lds_base + 2 * KBYTES + (4 * g + (lq >> 2)) * VSTR + (lq & 3) * 8;
    bf16x8 pf[2][2];
    volatile LAS unsigned* oflag = (volatile LAS unsigned*)((LAS unsigned char*)lds + LDS_MAIN) + 3;
    int safe = (KIND == 1 || ATT_FORCE == 1) ? 1 : 0;
    for (;;) {
#pragma unroll
    for (int db = 0; db < NDB; ++db) { O[db][0] = (f32x4){0.f, 0.f, 0.f, 0.f}; O[db][1] = (f32x4){0.f, 0.f, 0.f, 0.f}; }
#pragma unroll
    for (int qs = 0; qs < 2; ++qs) { mrun[qs] = 0.f; Ol[qs] = (f32x4){0.f, 0.f, 0.f, 0.f}; pf[qs][0] = (bf16x8){0, 0, 0, 0, 0, 0, 0, 0}; pf[qs][1] = (bf16x8){0, 0, 0, 0, 0, 0, 0, 0}; }
    if (KIND != 1 && tid == 0) oflag[0] = 0u;
    ATT_LOAD(0, 0); ATT_STORE(0, 0, 0);
    ATT_LOAD(1, 1);
    int vcur = 0, vprev = 2;
    for (int t2 = 0; t2 < nkt; t2 += 2) {
#pragma unroll
      for (int u = 0; u < 2; ++u) {
        const int t = t2 + u;
        const int buf = u;
        const int vnext = (vcur == 2) ? 0 : vcur + 1;
        __syncthreads();
        if (t + 1 < nkt) ATT_STORE(buf ^ 1, vnext, 1 - u);
        if (t + 2 < nkt) ATT_LOAD(t + 2, u);
        const unsigned char* Kb = lds + buf * KBYTES;
        if (skew && t > 0) ATT_PV(vprev);
        f32x4 s[4][2];
        __builtin_amdgcn_s_setprio(2);
#pragma unroll
        for (int kb = 0; kb < 4; ++kb) {
            const bf16x8 kf0 = *(const bf16x8*)(Kb + (kb * 16 + lq) * KSTR + (((comp * 8 + g) ^ ATT_KSW(lq)) * 16));
            const bf16x8 kf1 = *(const bf16x8*)(Kb + (kb * 16 + lq) * KSTR + (((comp * 8 + 4 + g) ^ ATT_KSW(lq)) * 16));
            if (KIND != 1 && safe) {
#pragma unroll
                for (int qs = 0; qs < 2; ++qs) {
                    f32x4 a = (f32x4){-mrun[qs], -mrun[qs], -mrun[qs], -mrun[qs]};
                    a = __builtin_amdgcn_mfma_f32_16x16x32_bf16(kf0, qf[qs][0], a, 0, 0, 0);
                    a = __builtin_amdgcn_mfma_f32_16x16x32_bf16(kf1, qf[qs][1], a, 0, 0, 0);
                    s[kb][qs] = a;
                }
            } else {
#pragma unroll
                for (int qs = 0; qs < 2; ++qs) {
                    f32x4 a = (f32x4){0.f, 0.f, 0.f, 0.f};
                    a = __builtin_amdgcn_mfma_f32_16x16x32_bf16(kf0, qf[qs][0], a, 0, 0, 0);
                    a = __builtin_amdgcn_mfma_f32_16x16x32_bf16(kf1, qf[qs][1], a, 0, 0, 0);
                    s[kb][qs] = a;
                }
            }
        }
        __builtin_amdgcn_s_setprio(0);
        if (KIND == 1) {
            const int kk0 = (kt0 + t) * 64;
            const int PF0 = kk0 < SEQ ? kk0 + CTXL : kk0 - SEQ;
            const int pfq_min = isctx ? qn0 : qn0 + CTXL, pbq_min = isctx ? SEQ + qn0 : qn0;
            const bool f_full = (pfq_min - PF0 - 63 >= 0), f_none = (pfq_min + 31 - PF0 < 0);
            const bool b_full = (kk0 - (pbq_min + 31) >= 0), b_none = (kk0 + 63 - pbq_min < 0);
            const bool clean = (f_full || f_none) && (b_full || b_none);
#pragma unroll
            for (int qs = 0; qs < 2; ++qs) {
                const int qpf = pfq_min + qs * 16 + lq, qpb = pbq_min + qs * 16 + lq;
                const int tf = qpf - PF0 - 4 * g, tb = qpb - kk0 - 4 * g;
                float cfk = f_none ? 0.f : __builtin_amdgcn_exp2f(lf2 * (float)(qpf - PF0)) * dfa0;
                float cbk = b_none ? 0.f : __builtin_amdgcn_exp2f(lb2 * (float)(kk0 - qpb)) * dba0;
                if (clean) {
#pragma unroll
                    for (int kb = 0; kb < 4; ++kb) {
#pragma unroll
                        for (int r = 0; r < 4; ++r) s[kb][qs][r] *= (cfk * dfr[r] + cbk * dbr[r]);
                        cfk *= f16; cbk *= b16; }
                } else {
#pragma unroll
                    for (int kb = 0; kb < 4; ++kb) {
#pragma unroll
                        for (int r = 0; r < 4; ++r) { const float w1 = (kb * 16 + r <= tf) ? cfk * dfr[r] : 0.f, w2 = (kb * 16 + r >= tb) ? cbk * dbr[r] : 0.f; s[kb][qs][r] *= (w1 + w2); }
                        cfk *= f16; cbk *= b16; }
                }
            }
        } else if (safe) {
            float mx[2];
#pragma unroll
            for (int qs = 0; qs < 2; ++qs) {
                float m0 = fmaxf(fmaxf(s[0][qs][0], s[0][qs][1]), fmaxf(s[0][qs][2], s[0][qs][3]));
#pragma unroll
                for (int kb = 1; kb < 4; ++kb) m0 = fmaxf(m0, fmaxf(fmaxf(s[kb][qs][0], s[kb][qs][1]), fmaxf(s[kb][qs][2], s[kb][qs][3])));
                { const unsigned u = __float_as_uint(m0); const auto r1 = __builtin_amdgcn_permlane16_swap(u, u, false, false); m0 = fmaxf(__uint_as_float(r1[0]), __uint_as_float(r1[1])); }
                { const unsigned u = __float_as_uint(m0); const auto r2 = __builtin_amdgcn_permlane32_swap(u, u, false, false); m0 = fmaxf(__uint_as_float(r2[0]), __uint_as_float(r2[1])); }
                mx[qs] = m0;
            }
            const bool need = (t == 0) || (mx[0] > 8.0f) || (mx[1] > 8.0f);
            if (__builtin_amdgcn_ballot_w64(need) != 0ull) {
#pragma unroll
                for (int qs = 0; qs < 2; ++qs) {
                    const float delta = (t == 0) ? mx[qs] : fmaxf(mx[qs], 0.f);
                    const float alpha = __builtin_amdgcn_exp2f(-delta);
                    mrun[qs] += delta; Ol[qs] *= alpha;
#pragma unroll
                    for (int db = 0; db < NDB; ++db) O[db][qs] *= alpha;
#pragma unroll
                    for (int kb = 0; kb < 4; ++kb) s[kb][qs] -= delta;
                }
            }
#pragma unroll
            for (int qs = 0; qs < 2; ++qs)
#pragma unroll
                for (int kb = 0; kb < 4; ++kb)
#pragma unroll
                    for (int r = 0; r < 4; ++r) s[kb][qs][r] = __builtin_amdgcn_exp2f(s[kb][qs][r]);
        } else {
#pragma unroll
            for (int qs = 0; qs < 2; ++qs)
#pragma unroll
                for (int kb = 0; kb < 4; ++kb)
#pragma unroll
                    for (int r = 0; r < 4; ++r) s[kb][qs][r] = __builtin_amdgcn_exp2f(s[kb][qs][r]);
        }
#pragma unroll
        for (int qs = 0; qs < 2; ++qs)
#pragma unroll
            for (int j = 0; j < 2; ++j) {
                u32x4 pk; pk.x = pk_bf16(s[2 * j][qs][0], s[2 * j][qs][1]); pk.y = pk_bf16(s[2 * j][qs][2], s[2 * j][qs][3]);
                pk.z = pk_bf16(s[2 * j + 1][qs][0], s[2 * j + 1][qs][1]); pk.w = pk_bf16(s[2 * j + 1][qs][2], s[2 * j + 1][qs][3]);
                pf[qs][j] = __builtin_bit_cast(bf16x8, pk);
            }
        if (KIND != 1) {
#pragma unroll
            for (int qs = 0; qs < 2; ++qs) { Ol[qs] = __builtin_amdgcn_mfma_f32_16x16x32_bf16(ones, pf[qs][0], Ol[qs], 0, 0, 0); Ol[qs] = __builtin_amdgcn_mfma_f32_16x16x32_bf16(ones, pf[qs][1], Ol[qs], 0, 0, 0); }
        }
        if (!skew) ATT_PV(vcur);
        vprev = vcur; vcur = vnext;
      }
    }
    __syncthreads();
    if (skew) ATT_PV(vprev);
    __syncthreads();
    if (KIND == 1 || safe) break;
    { bool bad = false;
#pragma unroll
      for (int qs = 0; qs < 2; ++qs) { const float lsum = Ol[qs][0]; bad = bad || !(lsum > 1e-30f && lsum < 1e30f); }
      if (__builtin_amdgcn_ballot_w64(bad) != 0ull && lane == 0) oflag[0] = 1u;
      __syncthreads();
      const unsigned redo = oflag[0] | (ATT_FORCE == 2 ? 1u : 0u);
      __syncthreads();
      if (!redo) break;
      safe = 1; }
    }
#undef ATT_PV
#undef ATT_TR
#undef ATT_KSW
#undef ATT_LOAD
#undef ATT_STORE
    if (KIND == 1 && !isctx) {
        const bf16_t* ST = (const bf16_t*)(p.ws + WS_RST) + ((size_t)((b * 4 + head) * 8 + qb) * 2) * 8192;
#pragma unroll
        for (int dir = 0; dir < 2; ++dir) {
            bf16x8 qsf[2][2];
#pragma unroll
            for (int qs = 0; qs < 2; ++qs) {
                const int m = w * 32 + qs * 16 + lq;
                const float cq = dir ? __builtin_amdgcn_exp2f(lb2 * (float)(256 - m)) : __builtin_amdgcn_exp2f(lf2 * (float)(m + 1));
#pragma unroll
                for (int ks = 0; ks < 2; ++ks) { const u32x4 r = __builtin_bit_cast(u32x4, qf[qs][ks]);
                    u32x4 o; o.x = pk_bf16(bf_lo(r.x) * cq, bf_hi(r.x) * cq); o.y = pk_bf16(bf_lo(r.y) * cq, bf_hi(r.y) * cq); o.z = pk_bf16(bf_lo(r.z) * cq, bf_hi(r.z) * cq); o.w = pk_bf16(bf_lo(r.w) * cq, bf_hi(r.w) * cq);
                    qsf[qs][ks] = __builtin_bit_cast(bf16x8, o); }
            }
#pragma unroll
            for (int db = 0; db < NDB; ++db)
#pragma unroll
                for (int ks = 0; ks < 2; ++ks) { const bf16x8 a = *(const bf16x8*)(ST + dir * 8192 + (16 * db + lq) * 64 + ks * 32 + g * 8);
#pragma unroll
                    for (int qs = 0; qs < 2; ++qs) O[db][qs] = __builtin_amdgcn_mfma_f32_16x16x32_bf16(a, qsf[qs][ks], O[db][qs], 0, 0, 0); }
        }
    }
    float linv[2] = {1.f, 1.f};
    if (KIND != 1) {
#pragma unroll
        for (int qs = 0; qs < 2; ++qs) linv[qs] = 1.0f / Ol[qs][0];
    }
    if (KIND == 2) {
#pragma unroll
        for (int qs = 0; qs < 2; ++qs) { bf16_t* op = P + (rowbase + qn0 + qs * 16 + lq) * QKVC + 3072 + head * 64 + 4 * g;
#pragma unroll
            for (int db = 0; db < NDB; ++db) { const f32x4 o = O[db][qs] * linv[qs]; u32x2 wv; wv.x = pk_bf16(o[0], o[1]); wv.y = pk_bf16(o[2], o[3]); if (!dummy) *(u32x2*)(op + db * 16) = wv; } }
    } else if (KIND == 1) {
        const float* ng = p.ret_norm_g + l * 128;
#pragma unroll
        for (int qs = 0; qs < 2; ++qs) {
            float ss = 0.f;
#pragma unroll
            for (int db = 0; db < NDB; ++db) { const f32x4 o = O[db][qs]; ss += o[0] * o[0] + o[1] * o[1] + o[2] * o[2] + o[3] * o[3]; }
            ss += __shfl_xor(ss, 16); ss += __shfl_xor(ss, 32);
            const float rn = rsqrtf(ss * (1.0f / 128.0f) + EPS);
            bf16_t* op = P + (rowbase + qn0 + qs * 16 + lq) * QKVC + 2560 + head * 128 + 4 * g;
#pragma unroll
            for (int db = 0; db < NDB; ++db) { const u32x2 gv = *(const u32x2*)(op + db * 16); const f32x4 gn = *(const f32x4*)(ng + db * 16 + 4 * g);
                const f32x4 o = O[db][qs] * rn * gn;
                u32x2 wv; wv.x = pk_bf16(o[0] * fast_silu(bf_lo(gv.x)), o[1] * fast_silu(bf_hi(gv.x))); wv.y = pk_bf16(o[2] * fast_silu(bf_lo(gv.y)), o[3] * fast_silu(bf_hi(gv.y)));
                if (!dummy) *(u32x2*)(op + db * 16) = wv; }
        }
    } else {
        float* X = (float*)lds;
        if (comp == 1) {
#pragma unroll
            for (int qs = 0; qs < 2; ++qs)
#pragma unroll
                for (int db = 0; db < NDB; ++db)
#pragma unroll
                    for (int r = 0; r < 4; ++r) X[(((w & 3) * 64) + (qs * NDB + db) * 4 + r) * 64 + lane] = O[db][qs][r] * linv[qs];
        }
        __syncthreads();
        if (comp == 0) {
            const float lam = misc[0], osc = 1.0f - misc[1];
            const float* ng = p.diff_norm_g + l * 128;
#pragma unroll
            for (int qs = 0; qs < 2; ++qs) {
                float ss = 0.f;
#pragma unroll
                for (int db = 0; db < NDB; ++db)
#pragma unroll
                    for (int r = 0; r < 4; ++r) { const float o = O[db][qs][r] * linv[qs] - lam * X[(((w & 3) * 64) + (qs * NDB + db) * 4 + r) * 64 + lane]; O[db][qs][r] = o; ss += o * o; }
                ss += __shfl_xor(ss, 16); ss += __shfl_xor(ss, 32);
                const float rn = rsqrtf(ss * (1.0f / 128.0f) + EPS) * osc;
                bf16_t* op = P + (rowbase + qn0 + qs * 16 + lq) * QKVC + head * 128 + 4 * g;
#pragma unroll
                for (int db = 0; db < NDB; ++db) { const f32x4 gn = *(const f32x4*)(ng + db * 16 + 4 * g); const f32x4 o = O[db][qs] * rn * gn;
                    u32x2 wv; wv.x = pk_bf16(o[0], o[1]); wv.y = pk_bf16(o[2], o[3]); if (!dummy) *(u32x2*)(op + db * 16) = wv; }
            }
        }
        __syncthreads();
    }
}

__device__ __forceinline__ void attn_phase(const Params& p, unsigned char* lds, int l, int dummy) {
    bf16_t* P = (bf16_t*)(p.ws + WS_P);
    const int G = (int)gridDim.x, bx = (int)blockIdx.x;
    const int vcu = (G % 8 == 0) ? (bx % 8) * (G / 8) + bx / 8 : bx;
    const bool last = (l == DEPTH - 1);
    const int nA = last ? 1024 : 1152, nB = last ? 512 : 576, nC = last ? 1024 : 1152;
#ifndef AKMASK
#define AKMASK 7
#endif
    int idx = vcu;
    for (; idx < nA; idx += G) {
        if (!(AKMASK & 1)) continue;
        const int ic = idx >= 1024, j = idx - 1024;
        attn_item<0>(lds, P, p, l, ic ? j >> 3 : idx >> 6, ic ? (j >> 1) & 3 : (idx >> 4) & 3, ic ? j & 1 : idx & 15, ic, dummy);
    }
    for (; idx < nA + nB; idx += G) {
        if (!(AKMASK & 2)) continue;
        const int j = idx - nA;
        const int ic = j >= 512, jj = j - 512;
        attn_item<1>(lds, P, p, l, ic ? jj >> 2 : j >> 5, ic ? jj & 3 : (j >> 3) & 3, ic ? 0 : j & 7, ic, dummy);
    }
    for (; idx < nA + nB + nC; idx += G) {
        if (!(AKMASK & 4)) continue;
        const int j = idx - nA - nB;
        const int ic = j >= 1024, jj = j - 1024;
        attn_item<2>(lds, P, p, l, ic ? jj >> 3 : j >> 6, ic ? jj & 7 : (j >> 3) & 7, ic ? 0 : j & 7, ic, dummy);
    }
}

#define XB_TMO      128
#define XB_XCNT(j)  (256  + 64 * (j))
#define XB_XSUB(j)  (1280 + 64 * (j))
#define XB_XGEN(j)  (2304 + 64 * (j))
#define XB_TOP      3328
#define XB_TOPGEN   3392
#define XCD_BAR_WORDS 3456
#define XB_SPIN_CAP (1u << 18)
__device__ __forceinline__ unsigned xb_ld(unsigned* p)              { return __hip_atomic_load(p, __ATOMIC_RELAXED, __HIP_MEMORY_SCOPE_AGENT); }
__device__ __forceinline__ unsigned xb_add(unsigned* p, unsigned v) { return __hip_atomic_fetch_add(p, v, __ATOMIC_RELAXED, __HIP_MEMORY_SCOPE_AGENT); }
__device__ __forceinline__ unsigned xb_xcc_id() { return (unsigned)__builtin_amdgcn_s_getreg((3 << 11) | 20) & 0xFu; }
#define XB_SPIN(cond, bar) do { unsigned _sp = 0; while (cond) { __builtin_amdgcn_s_sleep(1); \
    if ((++_sp & 255u) == 0u) { if (xb_ld(&(bar)[XB_TMO])) break; if (_sp > XB_SPIN_CAP) { atomicAdd(&(bar)[XB_TMO], 1u); break; } } } } while (0)
struct XcdBarrier { unsigned* bar; unsigned x; volatile LAS unsigned* st; };
__device__ __forceinline__ XcdBarrier xcd_barrier_post(unsigned* bar, volatile LAS unsigned* st) {
    XcdBarrier b; b.bar = bar; b.x = xb_xcc_id(); b.st = st;
    if (threadIdx.x == 0) (void)xb_add(&bar[XB_XCNT(b.x)], 1u);
    return b;
}
__device__ __forceinline__ void xcd_barrier_complete(unsigned* bar, unsigned x, unsigned& nloc, unsigned& nx) {
    const unsigned G = gridDim.x * gridDim.y * gridDim.z;
    unsigned sum, cnt, mine, sp = 0u;
    for (;;) {
        sum = 0u; cnt = 0u; mine = 0u;
#pragma unroll
        for (unsigned j = 0; j < 16; ++j) { const unsigned c = xb_ld(&bar[XB_XCNT(j)]); sum += c; cnt += (c > 0u) ? 1u : 0u; mine = (j == x) ? c : mine; }
        if (sum == G) break;
        __builtin_amdgcn_s_sleep(1);
        if ((++sp & 255u) == 0u) { if (xb_ld(&bar[XB_TMO])) break; if (sp > XB_SPIN_CAP) { atomicAdd(&bar[XB_TMO], 1u); break; } }
    }
    nloc = mine > 0u ? mine : 1u; nx = cnt > 0u ? cnt : 1u;
}
__device__ __forceinline__ void xcd_barrier(const XcdBarrier& b) {
    asm volatile("s_waitcnt vmcnt(0)" ::: "memory");
    __syncthreads();
    if (threadIdx.x == 0) {
        unsigned* bar = b.bar;
        __builtin_amdgcn_s_waitcnt(0);
        unsigned nloc = b.st[0], nx = b.st[1];
        if (nloc == 0u) { xcd_barrier_complete(bar, b.x, nloc, nx); b.st[0] = nloc; b.st[1] = nx; }
        const unsigned old = xb_add(&bar[XB_XSUB(b.x)], 1u);
        const unsigned gen = old / nloc;
        if (old + 1u == (gen + 1u) * nloc) {
            __builtin_amdgcn_fence(__ATOMIC_RELEASE, "agent");
            asm volatile("s_waitcnt vmcnt(0)" ::: "memory");
            const unsigned og = xb_add(&bar[XB_TOP], 1u);
            const unsigned tg = og / nx;
            if (og + 1u == (tg + 1u) * nx) xb_add(&bar[XB_TOPGEN], 1u);
            else XB_SPIN(xb_ld(&bar[XB_TOPGEN]) == tg, bar);
            __builtin_amdgcn_fence(__ATOMIC_ACQUIRE, "agent");
            xb_add(&bar[XB_XGEN(b.x)], 1u);
            asm volatile("s_waitcnt vmcnt(0)" ::: "memory");
        } else {
            XB_SPIN(xb_ld(&bar[XB_XGEN(b.x)]) == gen, bar);
            __builtin_amdgcn_fence(__ATOMIC_ACQUIRE, "agent");
            asm volatile("s_waitcnt vmcnt(0)" ::: "memory");
        }
    }
    __syncthreads();
}

constexpr int PPL = 13;
constexpr int NPH = 2 + PPL * DEPTH;
__device__ __forceinline__ int phase_k(int pos) { return pos < 4 ? pos : (pos == 4 ? 12 : (pos == 5 ? 13 : pos - 1)); }

__device__ __forceinline__ void run_phase(const Params& p, unsigned char* lds, int ph, int dummy) {
    float* lf = (float*)lds;
    LAS unsigned char* ldsl = (LAS unsigned char*)lds;
    bf16_t* P = (bf16_t*)(p.ws + WS_P);
    bf16_t* Y = (bf16_t*)(p.ws + WS_Y);
    unsigned char* G8 = p.ws + WS_G8;
#ifndef PHMASK
#define PHMASK 0xffff
#endif
    if (ph == 0 && (PHMASK & 1)) {
        const int total = 288 + 1 + CONV_FFN_TILES + CONV_MIX_TILES;
        unsigned* ctr = (unsigned*)(p.ws + WS_BAR) + 3600;
        volatile LAS unsigned* slot = (volatile LAS unsigned*)((LAS unsigned char*)lds + LDS_MAIN) + 2;
        for (;;) {
            if (threadIdx.x == 0) slot[0] = atomicAdd(ctr, 1u);
            __syncthreads();
            const int it = (int)slot[0];
            __syncthreads();
            if (it >= total) break;
            if (it < 288) mod_item(p, lf, it);
            else if (it == 288) misc_item(p);
            else if (it < 289 + CONV_FFN_TILES) conv_ffn(p, lf, 0, 0, it - 289);
            else conv_mix(p, lf, 0, it - 289 - CONV_FFN_TILES);
        }
        return;
    }
    if (ph == 0) return;
    if (ph == 1) { if (PHMASK & 2) ephase_rows(p, true, true, 0, 0, 0.f, Y, false, 0, 0, false, dummy); return; }
    const int l = (ph - 2) / PPL, k = phase_k((ph - 2) % PPL);
    const bool last = (l == DEPTH - 1);
    switch (k) {
    case 0: case 9: if (PHMASK & 4) {
        const int lat = (k == 9 && last) ? 1 : 0;
        pg8::Gemm g{Y, (const bf16_t*)(p.ws + WS_WFI), DM, DM, DM, 0};
        pg8::Order S; S.init(lat ? 128 : 144, 22, lat, 1, DM, DM); S.ntfull = DM / 64;
        pg8::EpiSwiglu E{P};
        pg8::gemm_phase<pg8::EpiSwiglu>(ldsl, g, S, E);
        if (k == 9 && !last) conv_tail(p, lds, 4 + l, CONV_MIX_TILES, 1, l + 1, 0);
    } break;
    case 1: case 7: case 10: if (PHMASK & 8) {
        const int lat = (k != 1 && last) ? 1 : 0;
        bf16_t* part = (bf16_t*)(p.ws + WS_PART);
        pg8::Gemm g; pg8::EpiPlain E;
        if (k == 7) { g = pg8::Gemm{Y, (const bf16_t*)(p.ws + WS_WMO), DM, DM, DM, 0}; E = pg8::EpiPlain{P, DM, part}; }
        else { g = pg8::Gemm{P, (const bf16_t*)(p.ws + WS_WFO), DFF, DFF, DFF, 0}; E = pg8::EpiPlain{Y, DM, part}; }
        pg8::Order S; S.init(128, 4, 1, 1, g.lda, g.ldb); S.ntfull = g.K / 64;
        if (!lat) { S.extra = 256; S.xmode = 2; S.nchunks = g.K / 128; }
        pg8::gemm_phase<pg8::EpiPlain>(ldsl, g, S, E);
        if (k == 10 && !last) conv_tail(p, lds, 7, 352, 0, l + 1, 0);
    } break;
    case 2: case 8: case 11: if (PHMASK & 2) {
        if (k == 11) { if (!last) for (int it = 352 + blockIdx.x; it < CONV_FFN_TILES; it += gridDim.x) conv_ffn(p, lf, l + 1, 0, it); }
        if (k == 2) ephase_rows(p, false, l == 0, l, 0, 0.5f, Y, true, l, 1, false, dummy);
        else if (k == 8) ephase_rows(p, false, false, l, 1, 1.0f, P, !last, l, 2, last, dummy);
        else ephase_rows(p, false, false, l, 2, 0.5f, Y, !last, last ? l : l + 1, last ? -1 : 0, last, dummy);
    } break;
    case 3: if (PHMASK & 16) {
        pg8::Gemm g{Y, (const bf16_t*)(p.ws + WS_WMI), DM, DM, DM, 0};
        pg8::Order S; S.init(last ? 128 : 144, 27, last ? 1 : 0, 1, DM, DM); S.ntfull = DM / 64;
        if (last) S.extra = 128;
        pg8::EpiQkvGate E{P, G8, p.b_gate + (size_t)l * GATEC, (const f32x2*)(p.ws + WS_ROPE), p.qk_norm_g + (size_t)(l * 2 + 1) * 64};
        pg8::gemm_phase<pg8::EpiQkvGate>(ldsl, g, S, E);
        conv_tail(p, lds, 1 + l, CONV_FFN_TILES, 0, l, 1);
    } break;
    case 4: if (PHMASK & 32) rope_phase(p, l, dummy); break;
    case 5: if (PHMASK & 64) attn_phase(p, lds, l, dummy); break;
    case 12: if (PHMASK & 64) rs1_phase(p, lds, l); break;
    case 13: if (PHMASK & 64) rs2_phase(p, l); break;
    case 6: if (PHMASK & 128) {
        const int lat = last ? 1 : 0;
        pg8::Gemm g{P, (const bf16_t*)(p.ws + WS_WMB), QKVC, 512, 512, 0};
        pg8::Order S; S.init(lat ? 128 : 144, 4, lat, 1, QKVC, 512); S.ntfull = 24;
        pg8::EpiMerge E{Y, G8};
        pg8::gemm_phase<pg8::EpiMerge, true>(ldsl, g, S, E, 2560 * 2, 512 * 2, (size_t)DM * 512 * 2);
    } break;
    }
}

__global__ void __launch_bounds__(NTHREADS) mk_fwd(Params p) {
    extern __shared__ __attribute__((aligned(16))) unsigned char lds[];
    volatile LAS unsigned* st = (volatile LAS unsigned*)((LAS unsigned char*)lds + LDS_MAIN);
    const bool multi = (p.ph_hi - p.ph_lo) > 1;
    XcdBarrier bar; bar.bar = (unsigned*)(p.ws + WS_BAR); bar.x = 0; bar.st = st;
    if (multi) {
        if (threadIdx.x < 4) st[threadIdx.x] = 0u;
        __syncthreads();
        bar = xcd_barrier_post((unsigned*)(p.ws + WS_BAR), st);
    }
    for (int ph = p.ph_lo; ph < p.ph_hi; ++ph) {
        int nrep = 1;
        if (PROBE_DUP) {
            const int k = ph < 2 ? -1 : phase_k((ph - 2) % PPL);
            const int kind = ph == 0 ? 1 : (ph == 1 || k == 2 || k == 8 || k == 11) ? 2 : (k == 0 || k == 9) ? 4 : (k == 1 || k == 7 || k == 10) ? 8 : k == 3 ? 16 : k == 4 ? 32 : (k == 5 || k >= 12) ? 64 : 128;
            if ((PROBE_DUP & kind) && p.probe) nrep = 2;
        }
        unsigned long long amp_t0 = 0ull; bool amp = false;
        if (PROBE_AMP) {
            const int k = ph < 2 ? -1 : phase_k((ph - 2) % PPL);
            const int kind = ph == 0 ? 1 : (ph == 1 || k == 2 || k == 8 || k == 11) ? 2 : (k == 0 || k == 9) ? 4 : (k == 1 || k == 7 || k == 10) ? 8 : k == 3 ? 16 : k == 4 ? 32 : (k == 5 || k >= 12) ? 64 : 128;
            amp = (PROBE_AMP & kind) && p.probe && (ph + 1 < p.ph_hi);
            if (amp) amp_t0 = __builtin_amdgcn_s_memrealtime();
        }
        for (int rep = 0; rep < nrep; ++rep) run_phase(p, lds, ph, rep + 1 < nrep ? 1 : 0);
        if (ph + 1 < p.ph_hi) {
            if (p.ph_hi > 1000) cg::this_grid().sync();
            xcd_barrier(bar);
            if ((PROBE_DUP & 256) && p.probe) xcd_barrier(bar);
            if (PROBE_AMP && amp) { const unsigned long long t1 = __builtin_amdgcn_s_memrealtime(); const unsigned long long until = t1 + 4ull * (t1 - amp_t0); while (__builtin_amdgcn_s_memrealtime() < until) __builtin_amdgcn_s_sleep(8); }
        }
    }
}

extern "C" void kernel_launch(void* const* d_in, const int* in_sizes, int n_in, void* d_out, int out_size, void* d_ws, size_t ws_size, hipStream_t stream) {
    static int grid = 0;
    if (grid == 0) {
        if (ws_size < WS_END) { fprintf(stderr, "kernel_launch: workspace too small: %zu < %zu\n", ws_size, (size_t)WS_END); grid = -1; return; }
        int dev = 0, cus = 0, per_cu = 0;
        hipGetDevice(&dev);
        hipDeviceGetAttribute(&cus, hipDeviceAttributeMultiprocessorCount, dev);
        if (hipFuncSetAttribute((const void*)mk_fwd, hipFuncAttributeMaxDynamicSharedMemorySize, LDS_BYTES) != hipSuccess) { fprintf(stderr, "kernel_launch: hipFuncSetAttribute failed\n"); grid = -1; return; }
        if (hipOccupancyMaxActiveBlocksPerMultiprocessor(&per_cu, (const void*)mk_fwd, NTHREADS, LDS_BYTES) != hipSuccess || per_cu < 1) { fprintf(stderr, "kernel_launch: occupancy query gave %d\n", per_cu); per_cu = 1; }
        (void)hipGetLastError();
        grid = cus * 1;
        if (grid <= 0) grid = 256;
    }
    if (grid < 0) return;
    Params p{};
    p.x = (const float*)d_in[0]; p.c = (const float*)d_in[1]; p.ctx = (const float*)d_in[2]; p.c_ctx = (const float*)d_in[3];
    p.w_mod = (const float*)d_in[4]; p.b_mod = (const float*)d_in[5]; p.norm_g = (const float*)d_in[6]; p.w_ffn_in = (const float*)d_in[7];
    p.w_ffn_out = (const float*)d_in[8]; p.w_in = (const float*)d_in[9]; p.b_gate = (const float*)d_in[10]; p.diff_lambda = (const float*)d_in[11];
    p.diff_norm_g = (const float*)d_in[12]; p.ret_logit = (const float*)d_in[13]; p.ret_norm_g = (const float*)d_in[14]; p.qk_norm_g = (const float*)d_in[15];
    p.w_branch = (const float*)d_in[16]; p.w_out = (const float*)d_in[17];
    p.out = (float*)d_out; p.ws = (unsigned char*)d_ws; p.probe = (PROBE_DUP || PROBE_AMP) ? 1 : 0;
    if (hipMemsetAsync((char*)d_ws + WS_BAR, 0, 16384, stream) != hipSuccess) { fprintf(stderr, "kernel_launch: memset of barrier / counter words failed\n"); return; }
#if MK_PER_PHASE
    for (int ph = 0; ph < NPH; ++ph) {
        p.ph_lo = ph; p.ph_hi = ph + 1;
        hipLaunchKernelGGL(mk_fwd, dim3(grid), dim3(NTHREADS), LDS_BYTES, stream, p);
    }
#else
    p.ph_lo = 0; p.ph_hi = NPH;
    void* args[] = {&p};
    hipError_t e = hipLaunchCooperativeKernel((const void*)mk_fwd, dim3(grid), dim3(NTHREADS), args, LDS_BYTES, stream);
    if (e != hipSuccess) fprintf(stderr, "cooperative launch failed: %s (grid %d)\n", hipGetErrorString(e), grid);
#endif
}
```
